# Optimizing an MI355X kernel written in HIP

```python
import jax, jax.numpy as jnp
from jax import lax
import numpy as np

D_MODEL = 1024
BATCH = 32
SEQ = 2048
DEPTH = 1

RW_HEADS = 8
RW_HEAD = 64
RW_WIDTH = RW_HEADS * RW_HEAD
DECAY_LORA = 64
AAA_LORA = 64
GATE_LORA = 128
SHIFT_WIDTH = 3
MLA_HEADS = 8
QK_NOPE = 64
QK_ROPE = 32
V_HEAD = 64
Q_LORA = 384
KV_LORA = 256
ROPE_THETA = 10000.0
Q_BLOCK = 128
D_FF = 4 * D_MODEL
LN_EPS = 1e-5
RMS_EPS = 1e-6
GN_EPS = 64e-5
L2_EPS = 1e-12
DN_ALPHA = (2.0 * DEPTH) ** 0.25
DN_BETA = (8.0 * DEPTH) ** -0.25

RW_SPLITS = (RW_WIDTH, RW_WIDTH, RW_WIDTH, DECAY_LORA, DECAY_LORA, AAA_LORA, AAA_LORA, GATE_LORA)
RW_COLS = sum(RW_SPLITS)
IN_SPLITS = (RW_COLS, Q_LORA, KV_LORA, QK_ROPE, D_MODEL, D_MODEL)
D_IN = sum(IN_SPLITS)

kernel_name = "hybrid_rwkv7_mla_gated_deepnorm_layer"


def _offsets(sizes):
    return [sum(sizes[:i + 1]) for i in range(len(sizes) - 1)]


def layer_norm(x, g, b):
    xf = x.astype(jnp.float32)
    mu = jnp.mean(xf, -1, keepdims=True)
    var = jnp.mean(jnp.square(xf - mu), -1, keepdims=True)
    return ((xf - mu) * lax.rsqrt(var + LN_EPS)).astype(x.dtype) * g + b


def rms_norm(x, g):
    xf = x.astype(jnp.float32)
    return (xf * lax.rsqrt(jnp.mean(xf * xf, -1, keepdims=True) + RMS_EPS)).astype(x.dtype) * g


def rope(x, pos):
    half = x.shape[-1] // 2
    inv = ROPE_THETA ** (-jnp.arange(half, dtype=jnp.float32) / half)
    ang = pos.astype(jnp.float32)[..., None] * inv
    ang = ang.reshape(ang.shape[:2] + (1,) * (x.ndim - 3) + (half,))
    cos, sin = jnp.cos(ang), jnp.sin(ang)
    xf = x.astype(jnp.float32)
    x1, x2 = xf[..., :half], xf[..., half:]
    return jnp.concatenate([x1 * cos - x2 * sin, x1 * sin + x2 * cos], -1).astype(x.dtype)


def centred_dwconv(x, w):
    pad = SHIFT_WIDTH // 2
    return lax.conv_general_dilated(
        x, w[:, None, :].astype(x.dtype), window_strides=(1,), padding=[(pad, pad)],
        dimension_numbers=("NWC", "WIO", "NWC"), feature_group_count=x.shape[-1])


def rwkv7_scan(r, w, k, v, a, b, reverse):
    def step(state, inp):
        r_t, w_t, k_t, v_t, a_t, b_t = inp
        sa = jnp.einsum("bhij,bhj->bhi", state, a_t)
        state = (state * w_t[:, :, None, :] + sa[..., None] * b_t[:, :, None, :]
                 + v_t[..., None] * k_t[:, :, None, :])
        return state, jnp.einsum("bhij,bhj->bhi", state, r_t)
    xs = tuple(jnp.moveaxis(t, 1, 0) for t in (r, w, k, v, a, b))
    s0 = jnp.zeros((r.shape[0], r.shape[2], r.shape[3], r.shape[3]), jnp.float32)
    _, y = lax.scan(step, s0, xs, reverse=reverse)
    return jnp.moveaxis(y, 0, 1)


def rwkv7_branch(z, conv_w, w0, w2, a0, a2, k_k, k_a, r_k, g2, lnx_g, lnx_b):
    B, S, _ = z.shape
    z = centred_dwconv(z, conv_w)
    r, k, v, zwf, zwb, zaf, zab, zg = jnp.split(z, _offsets(RW_SPLITS), axis=-1)
    heads = lambda t: t.astype(jnp.float32).reshape(B, S, RW_HEADS, RW_HEAD)
    pheads = lambda t: t.astype(jnp.float32).reshape(RW_HEADS, RW_HEAD)
    r_h, k_h, v_h = heads(r), heads(k), heads(v)
    kk = k_h * pheads(k_k)
    kk = kk / jnp.maximum(jnp.sqrt(jnp.sum(kk * kk, -1, keepdims=True)), L2_EPS)
    k_a_h = pheads(k_a)
    outs = []
    for d, (zw, za, rev) in enumerate(((zwf, zaf, False), (zwb, zab, True))):
        w_log = -jax.nn.softplus(-(pheads(w0[d]) + heads(jnp.tanh(zw.astype(jnp.float32)) @ w2[d]))) - 0.5
        decay = jnp.exp(-jnp.exp(w_log))
        a = jax.nn.sigmoid(pheads(a0[d]) + heads(za @ a2[d]))
        k_d = k_h * (1.0 + (a - 1.0) * k_a_h)
        outs.append(rwkv7_scan(r_h, decay, k_d, v_h, -kk, kk * a, rev))
    y = outs[0] + outs[1]
    mu = jnp.mean(y, -1, keepdims=True)
    var = jnp.mean(jnp.square(y - mu), -1, keepdims=True)
    y = ((y - mu) * lax.rsqrt(var + GN_EPS)).reshape(B, S, RW_WIDTH) * lnx_g + lnx_b
    bonus = (jnp.sum(r_h * k_h * pheads(r_k), -1, keepdims=True) * v_h).reshape(B, S, RW_WIDTH)
    g = jax.nn.sigmoid(zg) @ g2
    return ((y + bonus) * g).astype(z.dtype)


def mla_branch(z_q, z_kv, z_kr, pos, q_norm_g, kv_norm_g, w_uq, w_ukv):
    B, S, _ = z_q.shape
    q = (rms_norm(z_q, q_norm_g) @ w_uq).reshape(B, S, MLA_HEADS, QK_NOPE + QK_ROPE)
    q = jnp.concatenate([q[..., :QK_NOPE], rope(q[..., QK_NOPE:], pos)], -1)
    kv = (rms_norm(z_kv, kv_norm_g) @ w_ukv).reshape(B, S, MLA_HEADS, QK_NOPE + V_HEAD)
    k_pe = rope(z_kr, pos)
    k = jnp.concatenate(
        [kv[..., :QK_NOPE], jnp.broadcast_to(k_pe[:, :, None, :], (B, S, MLA_HEADS, QK_ROPE))], -1)
    v = kv[..., QK_NOPE:]
    scale = (QK_NOPE + QK_ROPE) ** -0.5
    n_blk = S // Q_BLOCK
    q_blocks = jnp.moveaxis(q.reshape(B, n_blk, Q_BLOCK, MLA_HEADS, QK_NOPE + QK_ROPE), 1, 0)

    def attend(qb):
        s = jnp.einsum("bqhd,bkhd->bhqk", qb, k).astype(jnp.float32) * scale
        p = jax.nn.softmax(s, axis=-1).astype(v.dtype)
        return jnp.einsum("bhqk,bkhv->bqhv", p, v)

    o = lax.map(attend, q_blocks)
    return jnp.moveaxis(o, 0, 1).reshape(B, S, MLA_HEADS * V_HEAD)


def setup_inputs(seed: int = 0) -> dict:
    key = jax.random.key(seed)
    ks = jax.random.split(key, 32)
    L = DEPTH
    nrm = lambda k, shape, s: jax.random.normal(k, shape, jnp.float32) * s

    x = nrm(ks[0], (BATCH, SEQ, D_MODEL), 1.0)
    c = nrm(ks[1], (BATCH, D_MODEL), 1.0)
    offs = jax.random.randint(ks[2], (BATCH, 1), 0, 64, dtype=jnp.int32)
    positions = jnp.arange(SEQ, dtype=jnp.int32)[None, :] + offs

    w_ada = nrm(ks[3], (L, D_MODEL, 6 * D_MODEL), 0.2 * D_MODEL ** -0.5)
    b_ada = nrm(ks[4], (L, 6 * D_MODEL), 0.01)

    w_in = nrm(ks[5], (L, D_MODEL, D_IN), D_MODEL ** -0.5)
    w_in = w_in.at[:, :, 2 * RW_WIDTH:3 * RW_WIDTH].multiply(DN_BETA)

    rw_conv = jnp.broadcast_to(jnp.array([0.25, 0.5, 0.25], jnp.float32)[None, :, None],
                               (L, SHIFT_WIDTH, RW_COLS)) + nrm(ks[6], (L, SHIFT_WIDTH, RW_COLS), 0.02)
    lin = jnp.linspace(0.0, 1.0, RW_WIDTH, dtype=jnp.float32) ** 0.9
    rw_w0 = (-6.0 + 5.0 * lin)[None, None, :] + nrm(ks[7], (L, 2, RW_WIDTH), 0.1)
    rw_w2 = nrm(ks[8], (L, 2, DECAY_LORA, RW_WIDTH), 0.1 * DECAY_LORA ** -0.5)
    rw_a0 = nrm(ks[9], (L, 2, RW_WIDTH), 0.1)
    rw_a2 = nrm(ks[10], (L, 2, AAA_LORA, RW_WIDTH), 0.5 * AAA_LORA ** -0.5)
    rw_k_k = 0.85 + nrm(ks[11], (L, RW_WIDTH), 0.02)
    rw_k_a = 1.0 + nrm(ks[12], (L, RW_WIDTH), 0.02)
    rw_r_k = nrm(ks[13], (L, RW_WIDTH), 0.1)
    rw_g2 = nrm(ks[14], (L, GATE_LORA, RW_WIDTH), GATE_LORA ** -0.5)
    rw_lnx_g = 1.0 + nrm(ks[15], (L, RW_WIDTH), 0.02)
    rw_lnx_b = nrm(ks[16], (L, RW_WIDTH), 0.02)

    mla_q_norm_g = 1.0 + nrm(ks[17], (L, Q_LORA), 0.02)
    mla_kv_norm_g = 1.0 + nrm(ks[18], (L, KV_LORA), 0.02)
    mla_w_uq = nrm(ks[19], (L, Q_LORA, MLA_HEADS * (QK_NOPE + QK_ROPE)), Q_LORA ** -0.5)
    mla_w_ukv = nrm(ks[20], (L, KV_LORA, MLA_HEADS, QK_NOPE + V_HEAD), KV_LORA ** -0.5)
    mla_w_ukv = mla_w_ukv.at[..., QK_NOPE:].multiply(DN_BETA).reshape(L, KV_LORA, MLA_HEADS * (QK_NOPE + V_HEAD))

    w_br_rwkv = nrm(ks[21], (L, RW_WIDTH, D_MODEL), DN_BETA * RW_WIDTH ** -0.5)
    w_br_mla = nrm(ks[22], (L, MLA_HEADS * V_HEAD, D_MODEL), DN_BETA * (MLA_HEADS * V_HEAD) ** -0.5)
    w_out = nrm(ks[23], (L, D_MODEL, D_MODEL), DN_BETA * D_MODEL ** -0.5)
    ln1_g = 1.0 + nrm(ks[24], (L, D_MODEL), 0.02)
    ln1_b = nrm(ks[25], (L, D_MODEL), 0.02)

    w_ff1 = nrm(ks[26], (L, D_MODEL, D_FF), D_MODEL ** -0.5)
    w_ff2 = nrm(ks[27], (L, D_FF, D_MODEL), DN_BETA * D_FF ** -0.5)
    ln2_g = 1.0 + nrm(ks[28], (L, D_MODEL), 0.02)
    ln2_b = nrm(ks[29], (L, D_MODEL), 0.02)

    return {"x": x, "c": c, "positions": positions, "w_ada": w_ada, "b_ada": b_ada, "w_in": w_in,
            "rw_conv": rw_conv, "rw_w0": rw_w0, "rw_w2": rw_w2, "rw_a0": rw_a0, "rw_a2": rw_a2,
            "rw_k_k": rw_k_k, "rw_k_a": rw_k_a, "rw_r_k": rw_r_k, "rw_g2": rw_g2,
            "rw_lnx_g": rw_lnx_g, "rw_lnx_b": rw_lnx_b, "mla_q_norm_g": mla_q_norm_g,
            "mla_kv_norm_g": mla_kv_norm_g, "mla_w_uq": mla_w_uq, "mla_w_ukv": mla_w_ukv,
            "w_br_rwkv": w_br_rwkv, "w_br_mla": w_br_mla, "w_out": w_out, "ln1_g": ln1_g, "ln1_b": ln1_b,
            "w_ff1": w_ff1, "w_ff2": w_ff2, "ln2_g": ln2_g, "ln2_b": ln2_b}


def reference(x, c, positions, w_ada, b_ada, w_in, rw_conv, rw_w0, rw_w2, rw_a0, rw_a2, rw_k_k, rw_k_a,
              rw_r_k, rw_g2, rw_lnx_g, rw_lnx_b, mla_q_norm_g, mla_kv_norm_g, mla_w_uq, mla_w_ukv,
              w_br_rwkv, w_br_mla, w_out, ln1_g, ln1_b, w_ff1, w_ff2, ln2_g, ln2_b):
    c_act = jax.nn.silu(c)
    for l in range(DEPTH):
        mod = (c_act @ w_ada[l] + b_ada[l])[:, None, :]
        shift1, scale1, gate1, shift2, scale2, gate2 = jnp.split(mod, 6, axis=-1)

        h = x * (1.0 + scale1) + shift1
        z = h @ w_in[l]
        z_rw, z_q, z_kv, z_kr, z_ga, z_gb = jnp.split(z, _offsets(IN_SPLITS), axis=-1)
        y_rw = rwkv7_branch(z_rw, rw_conv[l], rw_w0[l], rw_w2[l], rw_a0[l], rw_a2[l], rw_k_k[l],
                            rw_k_a[l], rw_r_k[l], rw_g2[l], rw_lnx_g[l], rw_lnx_b[l])
        y_mla = mla_branch(z_q, z_kv, z_kr, positions, mla_q_norm_g[l], mla_kv_norm_g[l],
                           mla_w_uq[l], mla_w_ukv[l])
        mixed = (jax.nn.sigmoid(z_ga) * (y_rw @ w_br_rwkv[l])
                 + jax.nn.sigmoid(z_gb) * (y_mla @ w_br_mla[l]))
        x = layer_norm(DN_ALPHA * x + (1.0 + gate1) * (mixed @ w_out[l]), ln1_g[l], ln1_b[l])

        h = x * (1.0 + scale2) + shift2
        ff = jnp.square(jax.nn.relu(h @ w_ff1[l])) @ w_ff2[l]
        x = layer_norm(DN_ALPHA * x + (1.0 + gate2) * ff, ln2_g[l], ln2_b[l])
    return x
```

```cpp
#include <hip/hip_runtime.h>
#include <hip/hip_cooperative_groups.h>
#include <stdint.h>
#include <stdio.h>
namespace cg = cooperative_groups;

#define DI __device__ __forceinline__
typedef unsigned short bf16_t;
typedef short bf16x8 __attribute__((ext_vector_type(8)));
typedef float f32x2 __attribute__((ext_vector_type(2)));
typedef float f32x4 __attribute__((ext_vector_type(4)));
typedef float f32x16 __attribute__((ext_vector_type(16)));
typedef unsigned u32x2 __attribute__((ext_vector_type(2)));
typedef unsigned u32x4 __attribute__((ext_vector_type(4)));
typedef __bf16 bf16x2_t __attribute__((ext_vector_type(2)));

constexpr int NB = 32, SEQ = 2048, DM = 1024, NTOK = NB * SEQ;
constexpr int DIN = 4640, DIN_PAD = 4864, DFF = 4096;
constexpr int NTHR = 512;
constexpr float DN_ALPHA = 1.189207115002721f;
constexpr size_t MiB = 1u << 20;
constexpr size_t OFF_MOD = 1 * MiB, OFF_PART = 512 * MiB, OFF_WIN = 8 * MiB, OFF_WFF1 = 18 * MiB, OFF_WFF2 = 26 * MiB, OFF_WOUT = 34 * MiB,
                 OFF_WBR1 = 36 * MiB, OFF_WBR2 = 37 * MiB, OFF_WUQ = 38 * MiB, OFF_WUKV = 39 * MiB, OFF_WW2 = 40 * MiB, OFF_WA2 = 40 * MiB + 262144,
                 OFF_WG2 = 40 * MiB + 524288, OFF_RSQ = 41 * MiB, OFF_RSKV = 41 * MiB + 524288, OFF_KINV = 42 * MiB, OFF_RKDOT = 44 * MiB, OFF_CS = 46 * MiB;
constexpr size_t OFF_HBF = 56 * MiB, OFF_TW = 56 * MiB, OFF_ZA = 72 * MiB, OFF_SG = 88 * MiB, OFF_YF = 104 * MiB;
constexpr size_t OFF_ZRW = 184 * MiB, OFF_Q = 184 * MiB, OFF_KN = 280 * MiB, OFF_VT = 344 * MiB, OFF_MIXED = 184 * MiB, OFF_HID = 184 * MiB;
constexpr size_t OFF_ZQ = 424 * MiB, OFF_ZKV = 472 * MiB, OFF_ZKR = 504 * MiB, OFF_KPE = 508 * MiB, OFF_YB = 424 * MiB;
constexpr size_t OFF_GA = 512 * MiB, OFF_GB = 640 * MiB;
constexpr size_t OFF_R = 768 * MiB, OFF_K = 832 * MiB, OFF_V = 896 * MiB, OFF_YRW = 768 * MiB, OFF_YMLA = 960 * MiB, OFF_T1 = 768 * MiB;

struct Params {
  const float *x, *c; const int* pos;
  const float *w_ada, *b_ada, *w_in, *rw_conv, *rw_w0, *rw_w2, *rw_a0, *rw_a2, *rw_k_k, *rw_k_a, *rw_r_k, *rw_g2, *rw_lnx_g, *rw_lnx_b,
      *q_norm_g, *kv_norm_g, *w_uq, *w_ukv, *w_br_rwkv, *w_br_mla, *w_out, *ln1_g, *ln1_b, *w_ff1, *w_ff2, *ln2_g, *ln2_b;
  float* out; char* ws;
};

DI unsigned pk2(float lo, float hi) { f32x2 v = {lo, hi}; bf16x2_t b = __builtin_convertvector(v, bf16x2_t); return __builtin_bit_cast(unsigned, b); }
DI unsigned short f2bf(float f) { return (unsigned short)(pk2(f, 0.f) & 0xffffu); }
DI float bf2f(unsigned short b) { return __uint_as_float(((unsigned)b) << 16); }
DI float bflo(unsigned u) { return __uint_as_float(u << 16); }
DI float bfhi(unsigned u) { return __uint_as_float(u & 0xffff0000u); }
DI float sigm(float x) { return 1.f / (1.f + __expf(-x)); }
template <int CTRL> DI float dppf(float x) { return __int_as_float(__builtin_amdgcn_update_dpp(0, __float_as_int(x), CTRL, 0xf, 0xf, true)); }
DI int tidx() { int t = __builtin_amdgcn_workitem_id_x(); asm volatile("" : "+v"(t)); return t; }
DI char* launder(char* p) { asm volatile("" : "+s"(p)); return p; }
DI float fma_s(float a, float b, float c) { float d; asm("v_fma_f32 %0, %1, %2, %3" : "=v"(d) : "v"(a), "v"(b), "v"(c)); return d; }
DI float mul_s(float a, float b) { float d; asm("v_mul_f32 %0, %1, %2" : "=v"(d) : "v"(a), "v"(b)); return d; }
DI float quad_sum(float x) { x += dppf<0xB1>(x); x += dppf<0x4E>(x); return x; }

DI void mod_partial_item(const Params& p, int item, char* smem) {
  const int nt = item % 24, kc = item / 24, tid = tidx(), k0 = kc * 128;
  float* sc = (float*)smem;
  for (int i = 0; i < 8; ++i) { const int idx = tid + 512 * i, b = idx >> 7, kk = idx & 127; const float v = p.c[b * DM + k0 + kk]; sc[kk * 32 + b] = v / (1.f + __expf(-v)); }
  __syncthreads();
  float acc[32];
#pragma unroll
  for (int b = 0; b < 32; ++b) acc[b] = 0.f;
  const int n = nt * 256 + (tid & 255), kh = (tid >> 8) * 64;
#pragma unroll 8
  for (int kk = kh; kk < kh + 64; ++kk) {
    const float w = p.w_ada[(size_t)(k0 + kk) * 6144 + n];
    const f32x4* s4 = (const f32x4*)(sc + kk * 32);
#pragma unroll
    for (int q = 0; q < 8; ++q) { const f32x4 s = s4[q]; acc[4 * q] += w * s[0]; acc[4 * q + 1] += w * s[1]; acc[4 * q + 2] += w * s[2]; acc[4 * q + 3] += w * s[3]; }
  }
  float* part = (float*)(p.ws + OFF_PART) + (size_t)(kc * 2 + (tid >> 8)) * 32 * 6144;
#pragma unroll
  for (int b = 0; b < 32; ++b) part[b * 6144 + n] = acc[b];
  __syncthreads();
}

DI void transpose_tile(const float* __restrict__ src, int N, bf16_t* dst, int ldd, int kt, int nt, const float* __restrict__ rowscale, int Nvalid, char* smem) {
  float* tile = (float*)smem;
  const int tid = tidx(), k0 = kt * 64, n0 = nt * 64, nn = tid & 63;
#pragma unroll
  for (int i = 0; i < 8; ++i) {
    const int kk = i * 8 + (tid >> 6);
    float v = 0.f;
    if (n0 + nn < Nvalid) { v = src[(size_t)(k0 + kk) * N + n0 + nn]; if (rowscale) v *= rowscale[k0 + kk]; }
    tile[kk * 65 + nn] = v;
  }
  __syncthreads();
  const int n = tid >> 3, kc = (tid & 7) * 8;
  unsigned w[4];
#pragma unroll
  for (int j = 0; j < 4; ++j) w[j] = pk2(tile[(kc + 2 * j) * 65 + n], tile[(kc + 2 * j + 1) * 65 + n]);
  bf16_t* d = dst + (size_t)(n0 + n) * ldd + k0 + kc;
  *(u32x4*)d = (u32x4){w[0], w[1], w[2], w[3]};
  __syncthreads();
}

DI void conv_item(const float* __restrict__ src, int N, bf16_t* dst, int ldd, int nb, int kc, const float* __restrict__ rowscale, int Nvalid, int Npad) {
  const int n = nb * 512 + tidx(), k0 = kc * 8;
  if (n >= Npad) return;
  float v[8];
#pragma unroll
  for (int j = 0; j < 8; ++j) v[j] = (n < Nvalid) ? src[(size_t)(k0 + j) * N + n] : 0.f;
  if (rowscale) {
#pragma unroll
    for (int j = 0; j < 8; ++j) v[j] *= rowscale[k0 + j];
  }
  *(u32x4*)(dst + (size_t)n * ldd + k0) = (u32x4){pk2(v[0], v[1]), pk2(v[2], v[3]), pk2(v[4], v[5]), pk2(v[6], v[7])};
}
DI void phase0a(const Params& p, char* smem) {
  char* ws = launder(p.ws);
  constexpr int N_MOD = 192;
  constexpr int T_IN = 10 * 128, T_FF1 = 8 * 128, T_FF2 = 2 * 512, T_OUT = 2 * 128, T_BR = 2 * 64, T_UQ = 2 * 48, T_UKV = 2 * 32, T_L = 8, T_G2 = 16;
  constexpr int E0 = N_MOD, E1 = E0 + T_IN, E2 = E1 + T_FF1, E3 = E2 + T_FF2, E4 = E3 + T_OUT, E5 = E4 + T_BR, E6 = E5 + T_BR, E7 = E6 + T_UQ, E8 = E7 + T_UKV,
                E9 = E8 + 2 * T_L, E10 = E9 + 2 * T_L, E11 = E10 + T_G2;
  for (int it = blockIdx.x; it < E11; it += gridDim.x) {
    if (it < E0) mod_partial_item(p, it, smem);
    else if (it < E1) { const int t = it - E0; conv_item(p.w_in, DIN, (bf16_t*)(ws + OFF_WIN), 1024, t % 10, t / 10, nullptr, DIN, DIN_PAD); }
    else if (it < E2) { const int t = it - E1; conv_item(p.w_ff1, DFF, (bf16_t*)(ws + OFF_WFF1), 1024, t % 8, t / 8, nullptr, DFF, DFF); }
    else if (it < E3) { const int t = it - E2; conv_item(p.w_ff2, DM, (bf16_t*)(ws + OFF_WFF2), DFF, t % 2, t / 2, nullptr, DM, DM); }
    else if (it < E4) { const int t = it - E3; conv_item(p.w_out, DM, (bf16_t*)(ws + OFF_WOUT), DM, t % 2, t / 2, nullptr, DM, DM); }
    else if (it < E5) { const int t = it - E4; conv_item(p.w_br_rwkv, DM, (bf16_t*)(ws + OFF_WBR1), 512, t % 2, t / 2, nullptr, DM, DM); }
    else if (it < E6) { const int t = it - E5; conv_item(p.w_br_mla, DM, (bf16_t*)(ws + OFF_WBR2), 512, t % 2, t / 2, nullptr, DM, DM); }
    else if (it < E7) { const int t = it - E6; conv_item(p.w_uq, 768, (bf16_t*)(ws + OFF_WUQ), 384, t % 2, t / 2, p.q_norm_g, 768, 768); }
    else if (it < E8) { const int t = it - E7; conv_item(p.w_ukv, 1024, (bf16_t*)(ws + OFF_WUKV), 256, t % 2, t / 2, p.kv_norm_g, 1024, 1024); }
    else if (it < E9) { const int t = it - E8, d = t / 8; conv_item(p.rw_w2 + d * 64 * 512, 512, (bf16_t*)(ws + OFF_WW2) + d * 512 * 64, 64, 0, t % 8, nullptr, 512, 512); }
    else if (it < E10) { const int t = it - E9, d = t / 8; conv_item(p.rw_a2 + d * 64 * 512, 512, (bf16_t*)(ws + OFF_WA2) + d * 512 * 64, 64, 0, t % 8, nullptr, 512, 512); }
    else { const int t = it - E10; conv_item(p.rw_g2, 512, (bf16_t*)(ws + OFF_WG2), 128, 0, t, nullptr, 512, 512); }
  }
}

DI void phase0b(const Params& p, char* smem) {
  const float* part = (const float*)(p.ws + OFF_PART);
  float* mod = (float*)(p.ws + OFF_MOD);
  const int tid = tidx();
  for (int m = blockIdx.x; m < 192; m += gridDim.x) {
    const int b = m / 6, seg = m % 6, col = seg * 1024 + (tid & 255) * 4;
    f32x4 v = *(const f32x4*)(p.b_ada + col);
    for (int kc = 0; kc < 16; ++kc) v += *(const f32x4*)(part + ((size_t)kc * 32 + b) * 6144 + col);
    if (tid < 256) *(f32x4*)(mod + b * 6144 + col) = v;
  }
  bf16_t* hbf = (bf16_t*)(p.ws + OFF_HBF);
  for (int t = blockIdx.x; t < NTOK / 128; t += gridDim.x) {
    const int row0 = t * 128, b = row0 / SEQ, col = (tid & 255) * 4;
    f32x4 sh = *(const f32x4*)(p.b_ada + col), sc = *(const f32x4*)(p.b_ada + 1024 + col);
    for (int kc = 0; kc < 16; ++kc) { const float* pp = part + ((size_t)kc * 32 + b) * 6144 + col; sh += *(const f32x4*)pp; sc += *(const f32x4*)(pp + 1024); }
    sc += 1.f;
#pragma unroll 8
    for (int r = tid >> 8; r < 128; r += 2) {
      const f32x4 xv = *(const f32x4*)(p.x + (size_t)(row0 + r) * DM + col);
      const f32x4 h = xv * sc + sh;
      *(u32x2*)(hbf + (size_t)(row0 + r) * DM + col) = (u32x2){pk2(h[0], h[1]), pk2(h[2], h[3])};
    }
  }
}

typedef __attribute__((address_space(3))) unsigned lds_u32_t;
DI void dma16(const void* g, char* l) { __builtin_amdgcn_global_load_lds((const unsigned*)g, (lds_u32_t*)l, 16, 0, 0); }
constexpr int MI = 8;
constexpr int GSTAGE = 32768;
template <bool PERMB = false>
DI void gemm_tile_acc(f32x4 (&acc)[MI][4], const bf16_t* A, int lda, const bf16_t* Bt, int ldb, int m0, int n0, int K, char* smem) {
  const int tid = tidx(), lane = tid & 63, wid = __builtin_amdgcn_readfirstlane(tid >> 6), wm = wid >> 2, wn = wid & 3;
  const int lr = lane >> 2, lch = (lane & 3) ^ ((lane >> 3) & 3);
  const bf16_t* Ag = A + (size_t)(m0 + wid * 32 + lr) * lda + lch * 8;
  const int brow = PERMB ? (8 * (lr >> 2) + (lr & 3)) : lr, bstep = PERMB ? 4 : 16;
  const bf16_t* Bg = Bt + (size_t)(n0 + wid * 32 + brow) * ldb + lch * 8;
  const int nk = K >> 5;
  const int fch = ((lane >> 4) ^ ((lane >> 1) & 3)) << 4;
  const int abase = (wm * 128 + (lane & 15)) * 64 + fch, bbase = 16384 + (wn * 64 + (lane & 15)) * 64 + fch;
  char* swa = smem + wid * 2048;
  char* swb = smem + 16384 + wid * 2048;
#define GEMM_ISSUE(kt_, st_) do { char* da_ = swa + (st_) * GSTAGE; char* db_ = swb + (st_) * GSTAGE; \
    _Pragma("unroll") for (int i_ = 0; i_ < 2; ++i_) dma16(Ag + (size_t)i_ * 16 * lda + (kt_) * 32, da_ + i_ * 1024); \
    _Pragma("unroll") for (int i_ = 0; i_ < 2; ++i_) dma16(Bg + (size_t)i_ * bstep * ldb + (kt_) * 32, db_ + i_ * 1024); } while (0)
  GEMM_ISSUE(0, 0);
  if (nk > 1) GEMM_ISSUE(1, 1);
  int st = 0, st2 = 2;
  for (int kt = 0; kt < nk; ++kt) {
    if (kt + 1 < nk) asm volatile("s_waitcnt vmcnt(4)" ::: "memory"); else asm volatile("s_waitcnt vmcnt(0)" ::: "memory");
    __builtin_amdgcn_s_barrier();
    asm volatile("" ::: "memory");
    const bool issue = kt + 2 < nk;
    char* da = swa + st2 * GSTAGE; char* db = swb + st2 * GSTAGE;
    const bf16_t* ga_ = Ag + (kt + 2) * 32; const bf16_t* gb_ = Bg + (kt + 2) * 32;
    const char* sp = smem + st * GSTAGE;
    bf16x8 bfr[4];
#pragma unroll
    for (int i = 0; i < 4; ++i) bfr[i] = *(const bf16x8*)(sp + bbase + i * 1024);
#pragma unroll
    for (int hf = 0; hf < 2; ++hf) {
      bf16x8 af[4];
#pragma unroll
      for (int i = 0; i < 4; ++i) af[i] = *(const bf16x8*)(sp + abase + (hf * 4 + i) * 1024);
#pragma unroll
      for (int mi = 0; mi < 4; ++mi) {
#pragma unroll
        for (int ni = 0; ni < 4; ++ni) acc[hf * 4 + mi][ni] = __builtin_amdgcn_mfma_f32_16x16x32_bf16(bfr[ni], af[mi], acc[hf * 4 + mi][ni], 0, 0, 0);
        const int pc = hf * 4 + mi;
        if (issue) { if (pc == 0 || pc == 2) dma16(ga_ + (size_t)(pc >> 1) * 16 * lda, da + (pc >> 1) * 1024); else if (pc == 4 || pc == 6) dma16(gb_ + (size_t)((pc - 4) >> 1) * bstep * ldb, db + ((pc - 4) >> 1) * 1024); }
      }
    }
    st = (st == 2) ? 0 : st + 1; st2 = (st2 == 2) ? 0 : st2 + 1;
  }
  asm volatile("s_waitcnt lgkmcnt(0)" ::: "memory");
  __builtin_amdgcn_s_barrier();
  asm volatile("" ::: "memory");
#undef GEMM_ISSUE
}
DI void zero_acc(f32x4 (&acc)[MI][4]) {
#pragma unroll
  for (int i = 0; i < MI; ++i)
#pragma unroll
    for (int j = 0; j < 4; ++j) acc[i][j] = (f32x4){0.f, 0.f, 0.f, 0.f};
}

template <class Epi, bool PERMB = false>
DI void gemm_phase(const bf16_t* A, int lda, const bf16_t* Bt, int ldb, int M, int N, int K, char* smem, const Epi& epi) {
  const int nN = N / 256, nT = (M / 256) * nN;
  const int lane = tidx() & 63, wid = tidx() >> 6;
  const int xg = blockIdx.x & 7, jg = blockIdx.x >> 3, per = gridDim.x >> 3;
  for (int t0 = 0; t0 < nT; t0 += gridDim.x) {
    int t = t0 + xg * per + jg;
    if (nN == 16 && gridDim.x == 256) { const int tmr = (xg >> 1) * 4 + (jg >> 3), tnr = (xg & 1) * 8 + (jg & 7); t = t0 + tmr * 16 + tnr; }
    if (t >= nT) continue;
    const int m0 = (t / nN) * 256, n0 = (t % nN) * 256;
    f32x4 acc[MI][4];
    zero_acc(acc);
    gemm_tile_acc<PERMB>(acc, A, lda, Bt, ldb, m0, n0, K, smem);
    epi(acc, m0 + (wid >> 2) * 128, n0 + (wid & 3) * 64, lane);
  }
}

struct EpiIn {
  char* ws;
  DI void operator()(f32x4 (&acc)[MI][4], int rb, int cb, int lane) const {
    bf16_t *zrw = (bf16_t*)(ws + OFF_ZRW), *zq = (bf16_t*)(ws + OFF_ZQ), *zkv = (bf16_t*)(ws + OFF_ZKV), *zkr = (bf16_t*)(ws + OFF_ZKR), *ga = (bf16_t*)(ws + OFF_GA), *gb = (bf16_t*)(ws + OFF_GB);
#pragma unroll
    for (int ni = 0; ni < 4; ++ni) {
      const int col = cb + ni * 16 + (lane >> 4) * 4;
      if (col >= DIN) continue;
#pragma unroll
      for (int mi = 0; mi < MI; ++mi) {
        int row_ = rb + mi * 16 + (lane & 15); asm volatile("" : "+v"(row_));
        const size_t row = row_;
        f32x4 v = acc[mi][ni];
        bf16_t* d;
        if (col < 1920) d = zrw + row * 1920 + col;
        else if (col < 2304) d = zq + row * 384 + (col - 1920);
        else if (col < 2560) d = zkv + row * 256 + (col - 2304);
        else if (col < 2592) d = zkr + row * 32 + (col - 2560);
        else {
          v = (f32x4){sigm(v[0]), sigm(v[1]), sigm(v[2]), sigm(v[3])};
          d = (col < 3616) ? ga + row * 1024 + (col - 2592) : gb + row * 1024 + (col - 3616);
        }
        *(u32x2*)d = (u32x2){pk2(v[0], v[1]), pk2(v[2], v[3])};
      }
    }
  }
};

constexpr float QSCALE = 0.10206207261596577f * 1.4426950408889634f;
struct EpiQ {
  char* ws;
  DI void operator()(f32x4 (&acc)[MI][4], int rb, int cb, int lane) const {
    bf16_t* Q = (bf16_t*)(ws + OFF_Q); const float* rsq = (const float*)(ws + OFF_RSQ); const float* cs = (const float*)(ws + OFF_CS);
#pragma unroll
    for (int mi = 0; mi < MI; ++mi) {
      if (!(mi & 1)) asm volatile("" ::: "memory");
      int row = rb + mi * 16 + (lane & 15); asm volatile("" : "+v"(row));
      const int b = row / SEQ, s = row % SEQ;
      const float rs = rsq[row] * QSCALE;
#pragma unroll
      for (int ni = 0; ni < 4; ++ni) {
        const int nt = (cb >> 4) + ni, h = nt / 6, sub = nt % 6;
        bf16_t* d = Q + ((size_t)(b * 8 + h) * SEQ + s) * 96;
        const int c4 = (lane >> 4) * 4;
        if (sub < 4) { const f32x4 v = acc[mi][ni] * rs; *(u32x2*)(d + sub * 16 + c4) = (u32x2){pk2(v[0], v[1]), pk2(v[2], v[3])}; }
        else if (sub == 4) {
          if (ni < 3) {
            const f32x4 x1 = acc[mi][ni] * rs, x2 = acc[mi][ni + 1 < 4 ? ni + 1 : 3] * rs;
            const f32x4 co = *(const f32x4*)(cs + (size_t)row * 32 + c4), si = *(const f32x4*)(cs + (size_t)row * 32 + 16 + c4);
            const f32x4 o1 = x1 * co - x2 * si, o2 = x1 * si + x2 * co;
            *(u32x2*)(d + 64 + c4) = (u32x2){pk2(o1[0], o1[1]), pk2(o1[2], o1[3])};
            *(u32x2*)(d + 80 + c4) = (u32x2){pk2(o2[0], o2[1]), pk2(o2[2], o2[3])};
          }
        }
      }
    }
  }
};
struct EpiKV {
  char* ws;
  DI void operator()(f32x4 (&acc)[MI][4], int rb, int cb, int lane) const {
    bf16_t* Kn = (bf16_t*)(ws + OFF_KN); bf16_t* VT = (bf16_t*)(ws + OFF_VT); const float* rskv = (const float*)(ws + OFF_RSKV);
    const int h = cb >> 7, isv = (cb >> 6) & 1;
#pragma unroll
    for (int mi = 0; mi < MI; ++mi) {
      if (!(mi & 1)) asm volatile("" ::: "memory");
      int row = rb + mi * 16 + (lane & 15); asm volatile("" : "+v"(row));
      const int b = row / SEQ, s = row % SEQ;
      const float rs = rskv[row];
#pragma unroll
      for (int ni = 0; ni < 4; ++ni) {
        const int d0 = ni * 16 + (lane >> 4) * 4;
        const f32x4 v = acc[mi][ni] * rs;
        if (!isv) *(u32x2*)(Kn + ((size_t)(b * 8 + h) * SEQ + s) * 64 + d0) = (u32x2){pk2(v[0], v[1]), pk2(v[2], v[3])};
        else {
          bf16_t* d = VT + ((size_t)(b * 8 + h) * 64 + d0) * SEQ + s;
          d[0] = f2bf(v[0]); d[SEQ] = f2bf(v[1]); d[2 * SEQ] = f2bf(v[2]); d[3 * SEQ] = f2bf(v[3]);
        }
      }
    }
  }
};
struct EpiG {
  char* ws; const float *lnx_g, *lnx_b;
  DI void operator()(f32x4 (&acc)[MI][4], int rb, int cb, int lane) const {
    const bf16_t *yf = (const bf16_t*)(ws + OFF_YF), *yb = (const bf16_t*)(ws + OFF_YB), *V = (const bf16_t*)(ws + OFF_V);
    const float* rkdot = (const float*)(ws + OFF_RKDOT); bf16_t* yrw = (bf16_t*)(ws + OFF_YRW);
    const int h = cb >> 6;
#pragma unroll
    for (int mi = 0; mi < MI; ++mi) {
      int row_ = rb + mi * 16 + (lane & 15); asm volatile("" : "+v"(row_) :: "memory");
      const size_t row = row_;
      f32x4 y[4]; float sum = 0.f;
#pragma unroll
      for (int ni = 0; ni < 4; ++ni) {
        const size_t o = row * 512 + cb + ni * 16 + (lane >> 4) * 4;
        const u32x2 a = *(const u32x2*)(yf + o), b2 = *(const u32x2*)(yb + o);
        y[ni] = (f32x4){bflo(a[0]) + bflo(b2[0]), bfhi(a[0]) + bfhi(b2[0]), bflo(a[1]) + bflo(b2[1]), bfhi(a[1]) + bfhi(b2[1])};
        sum += (y[ni][0] + y[ni][1]) + (y[ni][2] + y[ni][3]);
      }
      sum += __shfl_xor(sum, 16); sum += __shfl_xor(sum, 32);
      const float mean = sum * (1.f / 64.f);
      float q = 0.f;
#pragma unroll
      for (int ni = 0; ni < 4; ++ni) { const f32x4 dd = y[ni] - mean; q += (dd[0] * dd[0] + dd[1] * dd[1]) + (dd[2] * dd[2] + dd[3] * dd[3]); }
      q += __shfl_xor(q, 16); q += __shfl_xor(q, 32);
      const float rstd = rsqrtf(q * (1.f / 64.f) + 64e-5f);
      const float rk = rkdot[row * 8 + h];
#pragma unroll
      for (int ni = 0; ni < 4; ++ni) {
        const int col = cb + ni * 16 + (lane >> 4) * 4;
        const f32x4 g = *(const f32x4*)(lnx_g + col), be = *(const f32x4*)(lnx_b + col);
        const u32x2 vv = *(const u32x2*)(V + row * 512 + col);
        const f32x4 vf = (f32x4){bflo(vv[0]), bfhi(vv[0]), bflo(vv[1]), bfhi(vv[1])};
        const f32x4 o = ((y[ni] - mean) * rstd * g + be + vf * rk) * acc[mi][ni];
        *(u32x2*)(yrw + row * 512 + col) = (u32x2){pk2(o[0], o[1]), pk2(o[2], o[3])};
      }
      asm volatile("" ::: "memory");
    }
  }
};
struct EpiG8 {
  char* ws; const float *lnx_g, *lnx_b;
  DI void operator()(f32x4 (&acc)[MI][4], int rb, int cb, int lane) const {
    const bf16_t *yf = (const bf16_t*)(ws + OFF_YF), *yb = (const bf16_t*)(ws + OFF_YB), *V = (const bf16_t*)(ws + OFF_V);
    const float* rkdot = (const float*)(ws + OFF_RKDOT); bf16_t* yrw = (bf16_t*)(ws + OFF_YRW);
    const int h = cb >> 6;
#pragma unroll
    for (int mi = 0; mi < MI; ++mi) {
      int row_ = rb + mi * 16 + (lane & 15); asm volatile("" : "+v"(row_));
      const size_t row = row_;
      f32x4 y[4]; float sum = 0.f;
      u32x4 vv2[2];
#pragma unroll
      for (int pr = 0; pr < 2; ++pr) vv2[pr] = *(const u32x4*)(V + row * 512 + cb + pr * 32 + (lane >> 4) * 8);
      const float rk = rkdot[row * 8 + h];
#pragma unroll
      for (int pr = 0; pr < 2; ++pr) {
        const size_t o = row * 512 + cb + pr * 32 + (lane >> 4) * 8;
        const u32x4 a = *(const u32x4*)(yf + o), b2 = *(const u32x4*)(yb + o);
        y[2 * pr] = (f32x4){bflo(a[0]) + bflo(b2[0]), bfhi(a[0]) + bfhi(b2[0]), bflo(a[1]) + bflo(b2[1]), bfhi(a[1]) + bfhi(b2[1])};
        y[2 * pr + 1] = (f32x4){bflo(a[2]) + bflo(b2[2]), bfhi(a[2]) + bfhi(b2[2]), bflo(a[3]) + bflo(b2[3]), bfhi(a[3]) + bfhi(b2[3])};
        sum += ((y[2 * pr][0] + y[2 * pr][1]) + (y[2 * pr][2] + y[2 * pr][3])) + ((y[2 * pr + 1][0] + y[2 * pr + 1][1]) + (y[2 * pr + 1][2] + y[2 * pr + 1][3]));
      }
      sum += __shfl_xor(sum, 16); sum += __shfl_xor(sum, 32);
      const float mean = sum * (1.f / 64.f);
      float q = 0.f;
#pragma unroll
      for (int ni = 0; ni < 4; ++ni) { const f32x4 dd = y[ni] - mean; q += (dd[0] * dd[0] + dd[1] * dd[1]) + (dd[2] * dd[2] + dd[3] * dd[3]); }
      q += __shfl_xor(q, 16); q += __shfl_xor(q, 32);
      const float rstd = rsqrtf(q * (1.f / 64.f) + 64e-5f);
#pragma unroll
      for (int pr = 0; pr < 2; ++pr) {
        const int col = cb + pr * 32 + (lane >> 4) * 8;
        const u32x4 vv = vv2[pr];
        const f32x4 g0 = *(const f32x4*)(lnx_g + col), g1 = *(const f32x4*)(lnx_g + col + 4), be0 = *(const f32x4*)(lnx_b + col), be1 = *(const f32x4*)(lnx_b + col + 4);
        const f32x4 v0 = (f32x4){bflo(vv[0]), bfhi(vv[0]), bflo(vv[1]), bfhi(vv[1])}, v1 = (f32x4){bflo(vv[2]), bfhi(vv[2]), bflo(vv[3]), bfhi(vv[3])};
        const f32x4 o0 = ((y[2 * pr] - mean) * rstd * g0 + be0 + v0 * rk) * acc[mi][2 * pr];
        const f32x4 o1 = ((y[2 * pr + 1] - mean) * rstd * g1 + be1 + v1 * rk) * acc[mi][2 * pr + 1];
        *(u32x4*)(yrw + row * 512 + col) = (u32x4){pk2(o0[0], o0[1]), pk2(o0[2], o0[3]), pk2(o1[0], o1[1]), pk2(o1[2], o1[3])};
      }
      if (mi & 1) asm volatile("" ::: "memory");
    }
  }
};
struct EpiRes {
  const float* base; const float* gate; float* out;
  DI void operator()(f32x4 (&acc)[MI][4], int rb, int cb, int lane) const {
#pragma unroll
    for (int mi = 0; mi < MI; ++mi) {
      int row_ = rb + mi * 16 + (lane & 15); asm volatile("" : "+v"(row_) :: "memory");
      const size_t row = row_; const int b = (int)(row / SEQ);
#pragma unroll
      for (int ni = 0; ni < 4; ++ni) {
        const int col = cb + ni * 16 + (lane >> 4) * 4;
        const f32x4 g = *(const f32x4*)(gate + b * 6144 + col) + 1.f;
        const f32x4 xb = *(const f32x4*)(base + row * DM + col);
        *(f32x4*)(out + row * DM + col) = xb * DN_ALPHA + g * acc[mi][ni];
      }
      asm volatile("" ::: "memory");
    }
  }
};
struct EpiRelu2 {
  bf16_t* out;
  DI void operator()(f32x4 (&acc)[MI][4], int rb, int cb, int lane) const {
#pragma unroll
    for (int mi = 0; mi < MI; ++mi) {
      int row_ = rb + mi * 16 + (lane & 15); asm volatile("" : "+v"(row_) :: "memory");
      const size_t row = row_;
#pragma unroll
      for (int ni = 0; ni < 4; ++ni) {
        const int col = cb + ni * 16 + (lane >> 4) * 4;
        f32x4 v = acc[mi][ni];
#pragma unroll
        for (int j = 0; j < 4; ++j) { const float r = fmaxf(v[j], 0.f); v[j] = r * r; }
        *(u32x2*)(out + row * DFF + col) = (u32x2){pk2(v[0], v[1]), pk2(v[2], v[3])};
      }
    }
  }
};

namespace pg8 {
#define PG8_LAS __attribute__((address_space(3)))
typedef unsigned short bf16_t;
typedef short bf16x8 __attribute__((ext_vector_type(8)));
typedef float f32x4 __attribute__((ext_vector_type(4)));
typedef unsigned u32x4 __attribute__((ext_vector_type(4)));
constexpr int BM = 256, BK = 64, HALF = 128, HTB = HALF * BK * 2  , STAGE_BYTES = 8 * HTB, NXCD = 8, WGM = 8;

__host__ __device__ __forceinline__ int lds_byte(int r, int c) { const int st = (r >> 4) * 2 + (c >> 5), rr = r & 15, cc = c & 31, ob = rr * 64 + cc * 2; return st * 1024 + (ob ^ (((ob >> 9) & 1) << 5)); }
__host__ __device__ __forceinline__ void stage_rc(int b, int& R, int& C) { const int st = b / 1024, sb = b % 1024, swz = sb ^ (((sb >> 9) & 1) << 5); R = (st >> 1) * 16 + swz / 64; C = (st & 1) * 32 + (swz % 64) / 2; }
__host__ __device__ __forceinline__ int perm32(int rho) { const int n = rho >> 4, i = rho & 15; return 8 * (i >> 2) + 4 * n + (i & 3); }

struct Unit { int pm, pn; };
struct Gemm { const bf16_t* A; const bf16_t* Bt; int M, N, K; };

struct StaticOrder {
    int nM, nN, nwg, G, c;
    __host__ __device__ void init(int M, int N, int G_, int c_) { nM = M / BM; nN = N / BM; nwg = nM * nN; G = G_; c = c_; }
    __host__ __device__ bool next(int i, Unit& u) const {
        const long L = (long)i * G + c; if (L >= nwg) return false;
        int wgid = (int)L; { const int q = nwg / NXCD, r = nwg % NXCD, xcd = wgid % NXCD, off = wgid / NXCD; wgid = (xcd < r ? xcd * (q + 1) : r * (q + 1) + (xcd - r) * q) + off; }
        const int nig = WGM * nN, gid = wgid / nig, fm = gid * WGM, gsz = (nM - fm) < WGM ? (nM - fm) : WGM;
        u.pm = fm + ((wgid % nig) % gsz); u.pn = (wgid % nig) / gsz; return true;
    }
    __device__ __forceinline__ void a_ready(const Unit&) const {}
    __device__ __forceinline__ void done(const Unit&) const {}
};

template <class Epi, class Sched, bool ALIGN_EPI = false, bool SP2 = false>
__device__ __forceinline__ void gemm_phase(PG8_LAS unsigned char* lds, const Gemm g, const Sched& S, const Epi& E) {
    const int tid = ::tidx(), wid = __builtin_amdgcn_readfirstlane(tid >> 6), lane = tid & 63, wr = wid >> 2, wc = wid & 3, fr = lane & 15, fq = lane >> 4;
    const int K = g.K, nt = K / BK;
    unsigned voffA[2], voffB[2];
#pragma unroll
    for (int i = 0; i < 2; ++i) { int R, C; stage_rc(tid * 16 + i * 8192, R, C); const int Rb = Epi::PERM ? ((R & ~31) + perm32(R & 31)) : R;
        voffA[i] = (unsigned)(R * K + C) * 2u; voffB[i] = (unsigned)(Rb * K + C) * 2u; }
    const size_t kstep = (size_t)(BK * 2);
    const size_t hstep = (size_t)HALF * K * 2;
    const size_t tstep = 2 * hstep;
    const unsigned ldsw = (unsigned)wid * 1024u;
    const int aoff = lds_byte(wr * 64 + fr, fq * 8), boff = lds_byte(wc * 32 + fr, fq * 8);
#define PG8_SA(b, h) (((b) * 2 + (h)) * HTB)
#define PG8_SB(b, h) ((4 + (b) * 2 + (h)) * HTB)
#define PG8_STAGE(bufoff, gbase, voff) do { _Pragma("unroll") for (int _i = 0; _i < 2; ++_i) \
        __builtin_amdgcn_global_load_lds((const unsigned*)((const char*)(gbase) + (voff)[_i]), (PG8_LAS unsigned*)(lds + (bufoff) + ldsw + _i * 8192), 16, 0, 0); } while (0)
#define PG8_LDA(dst, b, h) do { _Pragma("unroll") for (int m = 0; m < 4; ++m) _Pragma("unroll") for (int k = 0; k < 2; ++k) dst[m][k] = *(const PG8_LAS bf16x8*)(lds + PG8_SA(b, h) + aoff + m * 2048 + k * 1024); } while (0)
#define PG8_LDB(dst, b, h) do { _Pragma("unroll") for (int n = 0; n < 2; ++n) _Pragma("unroll") for (int k = 0; k < 2; ++k) dst[n][k] = *(const PG8_LAS bf16x8*)(lds + PG8_SB(b, h) + boff + n * 2048 + k * 1024); } while (0)
#define PG8_MMA(ai, bj, At, Bt) do { __builtin_amdgcn_s_setprio(1); _Pragma("unroll") for (int m = 0; m < 4; ++m) _Pragma("unroll") for (int n = 0; n < 2; ++n) _Pragma("unroll") for (int k = 0; k < 2; ++k) \
        acc[ai][bj][m][n] = __builtin_amdgcn_mfma_f32_16x16x32_bf16(Bt[n][k], At[m][k], acc[ai][bj][m][n], 0, 0, 0); __builtin_amdgcn_s_setprio(0); } while (0)
#define PG8_WAIT_V(n) asm volatile("s_waitcnt vmcnt(" #n ")" ::: "memory")
#define PG8_WAIT_L(n) asm volatile("s_waitcnt lgkmcnt(" #n ")" ::: "memory")
#define PG8_BAR __builtin_amdgcn_s_barrier()
#define PG8_SCHED __builtin_amdgcn_sched_barrier(0)
    Unit cur, nxt; int ui = 0;
    if (!S.next(0, cur)) return;
    f32x4 acc[2][2][4][2];
#pragma unroll
    for (int a = 0; a < 2; ++a)
#pragma unroll
        for (int b = 0; b < 2; ++b)
#pragma unroll
            for (int m = 0; m < 4; ++m)
#pragma unroll
                for (int n = 0; n < 2; ++n) acc[a][b][m][n] = (f32x4){0.f, 0.f, 0.f, 0.f};
    bf16x8 At[4][2], B0[2][2], B1[2][2];
    const char* cA = (const char*)g.A + (size_t)cur.pm * tstep; const char* cB = (const char*)g.Bt + (size_t)cur.pn * tstep;
    S.a_ready(cur);
    if constexpr (SP2) {
        PG8_STAGE(PG8_SB(0, 0), cB, voffB); PG8_STAGE(PG8_SB(0, 1), cB + hstep, voffB); PG8_STAGE(PG8_SA(0, 0), cA, voffA); PG8_STAGE(PG8_SA(0, 1), cA + hstep, voffA);
        if (wr == 1) PG8_BAR;
        PG8_WAIT_V(2); PG8_BAR;
        PG8_STAGE(PG8_SB(1, 0), cB + kstep, voffB); PG8_STAGE(PG8_SA(1, 0), cA + kstep, voffA); PG8_STAGE(PG8_SB(1, 1), cB + hstep + kstep, voffB);
        PG8_WAIT_V(6); PG8_BAR;
    } else {
        PG8_STAGE(PG8_SB(0, 0), cB, voffB); PG8_STAGE(PG8_SA(0, 0), cA, voffA); PG8_STAGE(PG8_SB(0, 1), cB + hstep, voffB); PG8_STAGE(PG8_SA(0, 1), cA + hstep, voffA);
        if (wr == 1) PG8_BAR;
        PG8_WAIT_V(4); PG8_BAR;
        PG8_STAGE(PG8_SB(1, 0), cB + kstep, voffB); PG8_STAGE(PG8_SA(1, 0), cA + kstep, voffA); PG8_STAGE(PG8_SB(1, 1), cB + hstep + kstep, voffB);
        PG8_WAIT_V(6); PG8_BAR;
    }
    for (;;) {
        const bool has_next = S.next(ui + 1, nxt);
        const char* nA = has_next ? (const char*)g.A + (size_t)nxt.pm * tstep : cA; const char* nB = has_next ? (const char*)g.Bt + (size_t)nxt.pn * tstep : cB;
        for (int t = 0; t < nt; t += 2) {
            const bool last = (t == nt - 2);
            const char* a1 = cA + (size_t)(t + 1) * kstep;
            const char* a2 = last ? nA : cA + (size_t)(t + 2) * kstep; const char* b2 = last ? nB : cB + (size_t)(t + 2) * kstep;
            const char* a3 = a2 + kstep; const char* b3 = b2 + kstep;
            if (last && has_next) S.a_ready(nxt);
            if constexpr (SP2) {
            PG8_LDB(B0, 0, 0); PG8_LDB(B1, 0, 1); PG8_SCHED; PG8_LDA(At, 0, 0); PG8_STAGE(PG8_SA(1, 1), a1 + hstep, voffA);
            PG8_WAIT_V(8); PG8_WAIT_L(0); PG8_BAR; PG8_MMA(0, 0, At, B0); PG8_MMA(0, 1, At, B1); PG8_BAR; PG8_SCHED;
            PG8_LDA(At, 0, 1); PG8_STAGE(PG8_SB(0, 0), b2, voffB); PG8_STAGE(PG8_SB(0, 1), b2 + hstep, voffB); PG8_STAGE(PG8_SA(0, 0), a2, voffA);
            PG8_WAIT_V(8); PG8_WAIT_L(0); PG8_BAR; PG8_MMA(1, 0, At, B0); PG8_MMA(1, 1, At, B1); PG8_BAR; PG8_SCHED;
            PG8_LDB(B0, 1, 0); PG8_LDB(B1, 1, 1); PG8_SCHED; PG8_LDA(At, 1, 0); PG8_STAGE(PG8_SA(0, 1), a2 + hstep, voffA);
            PG8_WAIT_V(8); PG8_WAIT_L(0); PG8_BAR; PG8_MMA(0, 0, At, B0); PG8_MMA(0, 1, At, B1); PG8_BAR; PG8_SCHED;
            PG8_LDA(At, 1, 1); PG8_STAGE(PG8_SB(1, 0), b3, voffB); PG8_STAGE(PG8_SB(1, 1), b3 + hstep, voffB); PG8_STAGE(PG8_SA(1, 0), a3, voffA);
            PG8_WAIT_V(8); PG8_WAIT_L(0); PG8_BAR; PG8_MMA(1, 0, At, B0); PG8_MMA(1, 1, At, B1); PG8_BAR; PG8_SCHED;
            } else {
            PG8_LDB(B0, 0, 0); PG8_SCHED; PG8_LDA(At, 0, 0); PG8_STAGE(PG8_SA(1, 1), a1 + hstep, voffA);
            PG8_WAIT_L(8); PG8_BAR; PG8_WAIT_L(0); PG8_MMA(0, 0, At, B0); PG8_BAR; PG8_SCHED;
            PG8_LDB(B1, 0, 1); PG8_STAGE(PG8_SB(0, 0), b2, voffB);
            PG8_BAR; PG8_WAIT_L(0); PG8_MMA(0, 1, At, B1); PG8_BAR;
            PG8_LDA(At, 0, 1); PG8_STAGE(PG8_SA(0, 0), a2, voffA);
            PG8_BAR; PG8_WAIT_L(0); PG8_MMA(1, 0, At, B0); PG8_BAR; PG8_SCHED;
            PG8_STAGE(PG8_SB(0, 1), b2 + hstep, voffB);
            PG8_WAIT_V(6); PG8_BAR; PG8_MMA(1, 1, At, B1); PG8_BAR;
            PG8_LDB(B0, 1, 0); PG8_SCHED; PG8_LDA(At, 1, 0); PG8_STAGE(PG8_SA(0, 1), a2 + hstep, voffA);
            PG8_WAIT_L(8); PG8_BAR; PG8_WAIT_L(0); PG8_MMA(0, 0, At, B0); PG8_BAR; PG8_SCHED;
            PG8_LDB(B1, 1, 1); PG8_STAGE(PG8_SB(1, 0), b3, voffB);
            PG8_BAR; PG8_WAIT_L(0); PG8_MMA(0, 1, At, B1); PG8_BAR;
            PG8_LDA(At, 1, 1); PG8_STAGE(PG8_SA(1, 0), a3, voffA);
            PG8_BAR; PG8_WAIT_L(0); PG8_MMA(1, 0, At, B0); PG8_BAR; PG8_SCHED;
            PG8_STAGE(PG8_SB(1, 1), b3 + hstep, voffB);
            PG8_WAIT_V(6); PG8_BAR; PG8_MMA(1, 1, At, B1); PG8_BAR;
            }
        }
        if constexpr (ALIGN_EPI) { if (wr == 0) PG8_BAR; }
        if constexpr (!Epi::AFTER_DRAIN) { E(acc, cur, wr, wc, fr, fq); S.done(cur); }
        if (!has_next) break;
#pragma unroll
        for (int a = 0; a < 2; ++a)
#pragma unroll
            for (int b = 0; b < 2; ++b)
#pragma unroll
                for (int m = 0; m < 4; ++m)
#pragma unroll
                    for (int n = 0; n < 2; ++n) acc[a][b][m][n] = (f32x4){0.f, 0.f, 0.f, 0.f};
        cur = nxt; cA = nA; cB = nB; ++ui;
        if constexpr (ALIGN_EPI) { if (wr == 1) PG8_BAR; }
    }
    PG8_WAIT_V(0);
    if constexpr (!ALIGN_EPI) { if (wr == 0) PG8_BAR; }
    PG8_BAR;
    if constexpr (Epi::AFTER_DRAIN) { E.fused(acc, cur, wr, wc, fr, fq, lds, wid, lane); S.done(cur); }
#undef PG8_SA
#undef PG8_SB
#undef PG8_STAGE
#undef PG8_LDA
#undef PG8_LDB
#undef PG8_MMA
#undef PG8_WAIT_V
#undef PG8_WAIT_L
#undef PG8_BAR
#undef PG8_SCHED
}
}

template <class F> struct PgEpi {
  static constexpr bool PERM = false, AFTER_DRAIN = false;
  F f;
  __device__ __forceinline__ void operator()(const pg8::f32x4 (&acc)[2][2][4][2], const pg8::Unit& u, int wr, int wc, int fr, int fq) const {
#pragma unroll
    for (int ai = 0; ai < 2; ++ai)
#pragma unroll
      for (int m = 0; m < 4; ++m) {
        int row = u.pm * 256 + ai * 128 + wr * 64 + m * 16 + fr; asm volatile("" : "+v"(row));
#pragma unroll
        for (int bj = 0; bj < 2; ++bj)
#pragma unroll
          for (int n = 0; n < 2; ++n) {
            const int col = u.pn * 256 + bj * 128 + wc * 32 + n * 16 + fq * 4;
            const pg8::f32x4 a = acc[ai][bj][m][n];
            f.elem(row, col, (f32x4){a[0], a[1], a[2], a[3]});
          }
        if (m & 1) asm volatile("" ::: "memory");
      }
  }
};
struct InElem {
  char* ws;
  DI void elem8(int row_, int col, f32x4 v, f32x4 w) const {
    if (col >= DIN) return;
    const size_t row = row_;
    bf16_t* d;
    if (col < 1920) d = (bf16_t*)(ws + OFF_ZRW) + row * 1920 + col;
    else if (col < 2304) d = (bf16_t*)(ws + OFF_ZQ) + row * 384 + (col - 1920);
    else if (col < 2560) d = (bf16_t*)(ws + OFF_ZKV) + row * 256 + (col - 2304);
    else if (col < 2592) d = (bf16_t*)(ws + OFF_ZKR) + row * 32 + (col - 2560);
    else {
      v = (f32x4){sigm(v[0]), sigm(v[1]), sigm(v[2]), sigm(v[3])}; w = (f32x4){sigm(w[0]), sigm(w[1]), sigm(w[2]), sigm(w[3])};
      d = (col < 3616) ? (bf16_t*)(ws + OFF_GA) + row * 1024 + (col - 2592) : (bf16_t*)(ws + OFF_GB) + row * 1024 + (col - 3616);
    }
    *(u32x4*)d = (u32x4){pk2(v[0], v[1]), pk2(v[2], v[3]), pk2(w[0], w[1]), pk2(w[2], w[3])};
  }
  DI void elem(int row_, int col, f32x4 v) const {
    if (col >= DIN) return;
    const size_t row = row_;
    bf16_t* d;
    if (col < 1920) d = (bf16_t*)(ws + OFF_ZRW) + row * 1920 + col;
    else if (col < 2304) d = (bf16_t*)(ws + OFF_ZQ) + row * 384 + (col - 1920);
    else if (col < 2560) d = (bf16_t*)(ws + OFF_ZKV) + row * 256 + (col - 2304);
    else if (col < 2592) d = (bf16_t*)(ws + OFF_ZKR) + row * 32 + (col - 2560);
    else {
      v = (f32x4){sigm(v[0]), sigm(v[1]), sigm(v[2]), sigm(v[3])};
      d = (col < 3616) ? (bf16_t*)(ws + OFF_GA) + row * 1024 + (col - 2592) : (bf16_t*)(ws + OFF_GB) + row * 1024 + (col - 3616);
    }
    *(u32x2*)d = (u32x2){pk2(v[0], v[1]), pk2(v[2], v[3])};
  }
};
struct Relu2Elem {
  bf16_t* out;
  DI void elem8(int row_, int col, f32x4 v, f32x4 w) const {
#pragma unroll
    for (int j = 0; j < 4; ++j) { const float r = fmaxf(v[j], 0.f); v[j] = r * r; const float q = fmaxf(w[j], 0.f); w[j] = q * q; }
    *(u32x4*)(out + (size_t)row_ * DFF + col) = (u32x4){pk2(v[0], v[1]), pk2(v[2], v[3]), pk2(w[0], w[1]), pk2(w[2], w[3])};
  }
  DI void elem(int row_, int col, f32x4 v) const {
#pragma unroll
    for (int j = 0; j < 4; ++j) { const float r = fmaxf(v[j], 0.f); v[j] = r * r; }
    *(u32x2*)(out + (size_t)row_ * DFF + col) = (u32x2){pk2(v[0], v[1]), pk2(v[2], v[3])};
  }
};
struct ResElem {
  const float* base; const float* gate; float* out;
  DI void elem(int row_, int col, f32x4 v) const {
    const size_t row = row_; const int b = row_ / SEQ;
    const f32x4 g = *(const f32x4*)(gate + b * 6144 + col) + 1.f;
    const f32x4 xb = *(const f32x4*)(base + row * DM + col);
    *(f32x4*)(out + row * DM + col) = xb * DN_ALPHA + g * v;
  }
};
template <class F> struct PgEpi8 {
  static constexpr bool PERM = true, AFTER_DRAIN = false;
  F f;
  __device__ __forceinline__ void operator()(const pg8::f32x4 (&acc)[2][2][4][2], const pg8::Unit& u, int wr, int wc, int fr, int fq) const {
#pragma unroll
    for (int ai = 0; ai < 2; ++ai)
#pragma unroll
      for (int m = 0; m < 4; ++m) {
        int row = u.pm * 256 + ai * 128 + wr * 64 + m * 16 + fr; asm volatile("" : "+v"(row));
#pragma unroll
        for (int bj = 0; bj < 2; ++bj) {
          const int col = u.pn * 256 + bj * 128 + wc * 32 + fq * 8;
          const pg8::f32x4 a = acc[ai][bj][m][0], b = acc[ai][bj][m][1];
          f.elem8(row, col, (f32x4){a[0], a[1], a[2], a[3]}, (f32x4){b[0], b[1], b[2], b[3]});
        }
        if (m & 1) asm volatile("" ::: "memory");
      }
  }
};
struct MixElem {
  const bf16_t* gate; bf16_t* mixed; int pass;
  DI void elem8(int row_, int col, f32x4 v, f32x4 w) const {
    const size_t o = (size_t)row_ * DM + col;
    const u32x4 g = *(const u32x4*)(gate + o);
    v *= (f32x4){bflo(g[0]), bfhi(g[0]), bflo(g[1]), bfhi(g[1])}; w *= (f32x4){bflo(g[2]), bfhi(g[2]), bflo(g[3]), bfhi(g[3])};
    if (pass) { const u32x4 mm = *(const u32x4*)(mixed + o);
      v += (f32x4){bflo(mm[0]), bfhi(mm[0]), bflo(mm[1]), bfhi(mm[1])}; w += (f32x4){bflo(mm[2]), bfhi(mm[2]), bflo(mm[3]), bfhi(mm[3])}; }
    *(u32x4*)(mixed + o) = (u32x4){pk2(v[0], v[1]), pk2(v[2], v[3]), pk2(w[0], w[1]), pk2(w[2], w[3])};
  }
};
template <class F>
DI void pg8_gemm8(char* smem, const bf16_t* A, const bf16_t* Bt, int M, int N, int K, const F& f) {
  pg8::StaticOrder S; S.init(M, N, (int)gridDim.x, (int)blockIdx.x);
  PgEpi8<F> E{f};
  pg8::gemm_phase<PgEpi8<F>, pg8::StaticOrder, true, true>((PG8_LAS unsigned char*)smem, pg8::Gemm{A, Bt, M, N, K}, S, E);
}
struct Res2Elem {
  const float* t1; const float* stats; const float *g1, *b1; const float* gate; float* out;
  DI void elem(int row_, int col, f32x4 v) const {
    const size_t row = row_; const int b = row_ / SEQ;
    const f32x2 st = *(const f32x2*)(stats + row * 2);
    const f32x4 x1 = (*(const f32x4*)(t1 + row * DM + col) - st[0]) * st[1] * *(const f32x4*)(g1 + col) + *(const f32x4*)(b1 + col);
    const f32x4 g = *(const f32x4*)(gate + b * 6144 + col) + 1.f;
    *(f32x4*)(out + row * DM + col) = x1 * DN_ALPHA + g * v;
  }
};
template <class F>
DI void pg8_gemm(char* smem, const bf16_t* A, const bf16_t* Bt, int M, int N, int K, const F& f) {
  pg8::StaticOrder S; S.init(M, N, (int)gridDim.x, (int)blockIdx.x);
  PgEpi<F> E{f};
  pg8::gemm_phase<PgEpi<F>, pg8::StaticOrder, true, true>((PG8_LAS unsigned char*)smem, pg8::Gemm{A, Bt, M, N, K}, S, E);
}

DI void conv8(float (&o)[8], const bf16_t* zrow, int col, bool hp, bool hn, const float* __restrict__ cw) {
  const u32x4 zc = *(const u32x4*)(zrow + col);
  u32x4 zp = (u32x4){0, 0, 0, 0}, zn = (u32x4){0, 0, 0, 0};
  if (hp) zp = *(const u32x4*)(zrow - 1920 + col);
  if (hn) zn = *(const u32x4*)(zrow + 1920 + col);
#pragma unroll
  for (int e = 0; e < 4; ++e) {
    const f32x2 w0 = *(const f32x2*)(cw + col + 2 * e), w1 = *(const f32x2*)(cw + 1920 + col + 2 * e), w2 = *(const f32x2*)(cw + 3840 + col + 2 * e);
    o[2 * e] = w0[0] * bflo(zp[e]) + w1[0] * bflo(zc[e]) + w2[0] * bflo(zn[e]);
    o[2 * e + 1] = w0[1] * bfhi(zp[e]) + w1[1] * bfhi(zc[e]) + w2[1] * bfhi(zn[e]);
  }
}
DI void load_cw(float (&w)[24], const float* __restrict__ cw, int col) {
#pragma unroll
  for (int j = 0; j < 3; ++j)
#pragma unroll
    for (int e = 0; e < 4; ++e) { const f32x2 t = *(const f32x2*)(cw + j * 1920 + col + 2 * e); w[j * 8 + 2 * e] = t[0]; w[j * 8 + 2 * e + 1] = t[1]; }
}
DI void conv8w(float (&o)[8], const bf16_t* zrow, int col, bool hp, bool hn, const float (&w)[24]) {
  const u32x4 zc = *(const u32x4*)(zrow + col);
  u32x4 zp = (u32x4){0, 0, 0, 0}, zn = (u32x4){0, 0, 0, 0};
  if (hp) zp = *(const u32x4*)(zrow - 1920 + col);
  if (hn) zn = *(const u32x4*)(zrow + 1920 + col);
#pragma unroll
  for (int e = 0; e < 4; ++e) {
    o[2 * e] = w[2 * e] * bflo(zp[e]) + w[8 + 2 * e] * bflo(zc[e]) + w[16 + 2 * e] * bflo(zn[e]);
    o[2 * e + 1] = w[2 * e + 1] * bfhi(zp[e]) + w[8 + 2 * e + 1] * bfhi(zc[e]) + w[16 + 2 * e + 1] * bfhi(zn[e]);
  }
}
DI u32x4 pack8(const float (&o)[8]) { return (u32x4){pk2(o[0], o[1]), pk2(o[2], o[3]), pk2(o[4], o[5]), pk2(o[6], o[7])}; }

struct ZL3 { u32x4 c, p, n; };
DI void load_z3(ZL3& z, const bf16_t* zrow, int col, bool hp, bool hn) {
  z.c = *(const u32x4*)(zrow + col);
  z.p = (u32x4){0, 0, 0, 0}; z.n = (u32x4){0, 0, 0, 0};
  if (hp) z.p = *(const u32x4*)(zrow - 1920 + col);
  if (hn) z.n = *(const u32x4*)(zrow + 1920 + col);
}
DI void conv_z3(float (&o)[8], const ZL3& z, const float (&w)[24]) {
#pragma unroll
  for (int e = 0; e < 4; ++e) {
    o[2 * e] = w[2 * e] * bflo(z.p[e]) + w[8 + 2 * e] * bflo(z.c[e]) + w[16 + 2 * e] * bflo(z.n[e]);
    o[2 * e + 1] = w[2 * e + 1] * bfhi(z.p[e]) + w[8 + 2 * e + 1] * bfhi(z.c[e]) + w[16 + 2 * e + 1] * bfhi(z.n[e]);
  }
}
DI void phase2(const Params& p) {
  char* ws = launder(p.ws);
  const bf16_t* zrw = (const bf16_t*)(ws + OFF_ZRW);
  bf16_t *R = (bf16_t*)(ws + OFF_R), *K = (bf16_t*)(ws + OFF_K), *V = (bf16_t*)(ws + OFF_V), *TW = (bf16_t*)(ws + OFF_TW), *ZA = (bf16_t*)(ws + OFF_ZA), *SG = (bf16_t*)(ws + OFF_SG);
  float *kinv = (float*)(ws + OFF_KINV), *rkdot = (float*)(ws + OFF_RKDOT), *rsq = (float*)(ws + OFF_RSQ), *rskv = (float*)(ws + OFF_RSKV), *cs = (float*)(ws + OFF_CS);
  const bf16_t *zq = (const bf16_t*)(ws + OFF_ZQ), *zkv = (const bf16_t*)(ws + OFF_ZKV), *zkr = (const bf16_t*)(ws + OFF_ZKR);
  bf16_t* kpe = (bf16_t*)(ws + OFF_KPE);
  const int lane = tidx() & 63, wid = tidx() >> 6;
  const float invf = powf(10000.f, -(float)(lane & 15) * (1.f / 16.f));
  float cwr[24], cwk[24], cwv[24], kkw[8], rkw[8];
  load_cw(cwr, p.rw_conv, 8 * lane); load_cw(cwk, p.rw_conv, 512 + 8 * lane); load_cw(cwv, p.rw_conv, 1024 + 8 * lane);
  float cwx[24];
  load_cw(cwx, p.rw_conv, 1536 + 8 * (lane < 48 ? lane : 0));
#pragma unroll
  for (int e = 0; e < 8; ++e) { kkw[e] = p.rw_k_k[8 * lane + e]; rkw[e] = p.rw_r_k[8 * lane + e]; }
  const int l47 = lane < 48 ? lane : 47, l31 = lane & 31, l15 = lane & 15;
  for (int tok = blockIdx.x * 8 + wid; tok < NTOK; tok += gridDim.x * 8) {
    const int s = tok % SEQ; const bool hp = s > 0, hn = s < SEQ - 1;
    const bf16_t* zrow = zrw + (size_t)tok * 1920;
    ZL3 zr, zk, zv, zx;
    load_z3(zr, zrow, 8 * lane, hp, hn); load_z3(zk, zrow, 512 + 8 * lane, hp, hn); load_z3(zv, zrow, 1024 + 8 * lane, hp, hn);
    load_z3(zx, zrow, 1536 + 8 * l47, hp, hn);
    const u32x4 zqv = *(const u32x4*)(zq + (size_t)tok * 384 + 8 * l47);
    const u32x4 zkvv = *(const u32x4*)(zkv + (size_t)tok * 256 + 8 * l31);
    const unsigned short kr1 = zkr[(size_t)tok * 32 + l15], kr2 = zkr[(size_t)tok * 32 + 16 + l15];
    const int posv = p.pos[tok];
    float r8[8], k8[8], v8[8];
    conv_z3(r8, zr, cwr); conv_z3(k8, zk, cwk); conv_z3(v8, zv, cwv);
    *(u32x4*)(R + (size_t)tok * 512 + 8 * lane) = pack8(r8);
    *(u32x4*)(K + (size_t)tok * 512 + 8 * lane) = pack8(k8);
    *(u32x4*)(V + (size_t)tok * 512 + 8 * lane) = pack8(v8);
    float ss = 0.f, rk = 0.f;
#pragma unroll
    for (int e = 0; e < 8; ++e) { const float kk = k8[e] * kkw[e]; ss += kk * kk; rk += r8[e] * k8[e] * rkw[e]; }
    ss += __shfl_xor(ss, 1); ss += __shfl_xor(ss, 2); ss += __shfl_xor(ss, 4);
    rk += __shfl_xor(rk, 1); rk += __shfl_xor(rk, 2); rk += __shfl_xor(rk, 4);
    if ((lane & 7) == 0) { kinv[(size_t)tok * 8 + (lane >> 3)] = 1.f / fmaxf(sqrtf(ss), 1e-12f); rkdot[(size_t)tok * 8 + (lane >> 3)] = rk; }
    if (lane < 48) {
      float o[8];
      conv_z3(o, zx, cwx);
      if (lane < 16) {
#pragma unroll
        for (int e = 0; e < 8; ++e) o[e] = 1.f - 2.f / (1.f + __expf(2.f * o[e]));
        *(u32x4*)(TW + (size_t)tok * 128 + 8 * lane) = pack8(o);
      } else if (lane < 32) {
        *(u32x4*)(ZA + (size_t)tok * 128 + 8 * (lane - 16)) = pack8(o);
      } else {
#pragma unroll
        for (int e = 0; e < 8; ++e) o[e] = sigm(o[e]);
        *(u32x4*)(SG + (size_t)tok * 128 + 8 * (lane - 32)) = pack8(o);
      }
    }
    float sq = 0.f, skv = 0.f;
    if (lane < 48) {
#pragma unroll
      for (int e = 0; e < 4; ++e) { const float a = bflo(zqv[e]), b2 = bfhi(zqv[e]); sq += a * a + b2 * b2; } }
    if (lane < 32) {
#pragma unroll
      for (int e = 0; e < 4; ++e) { const float a = bflo(zkvv[e]), b2 = bfhi(zkvv[e]); skv += a * a + b2 * b2; } }
#pragma unroll
    for (int m = 1; m < 64; m <<= 1) { sq += __shfl_xor(sq, m); skv += __shfl_xor(skv, m); }
    if (lane == 0) { rsq[tok] = rsqrtf(sq * (1.f / 384.f) + 1e-6f); rskv[tok] = rsqrtf(skv * (1.f / 256.f) + 1e-6f); }
    if (lane < 16) {
      const float ang = (float)posv * invf;
      float si, co; sincosf(ang, &si, &co);
      cs[(size_t)tok * 32 + lane] = co; cs[(size_t)tok * 32 + 16 + lane] = si;
      const float x1 = bf2f(kr1), x2 = bf2f(kr2);
      kpe[(size_t)tok * 32 + lane] = f2bf(x1 * co - x2 * si);
      kpe[(size_t)tok * 32 + 16 + lane] = f2bf(x1 * si + x2 * co);
    }
  }
}

DI void scan_item(const Params& p, int pair, char* smem0) {
  char* ws = launder(p.ws);
  const int tid = tidx(), lane = tid & 63, w = (tid >> 6) & 3, half = __builtin_amdgcn_readfirstlane(tid >> 8);
  const int item = pair * 2 + half;
  const int dir = item & 1, h = (item >> 1) & 7, b = item >> 4;
  char* smem = smem0 + half * 53248;
  float* opbuf = (float*)smem;
  float* ybuf = (float*)(smem + 49152) + w * 256;
  const bf16_t *R = (const bf16_t*)(ws + OFF_R), *K = (const bf16_t*)(ws + OFF_K), *V = (const bf16_t*)(ws + OFF_V), *TW = (const bf16_t*)(ws + OFF_TW), *ZA = (const bf16_t*)(ws + OFF_ZA);
  const float* kinv = (const float*)(ws + OFF_KINV);
  bf16_t* Y = (bf16_t*)(ws + (dir ? OFF_YB : OFF_YF));
  const int n = w * 16 + (lane & 15), gc = h * 64 + n;
  bf16x8 bw[2], ba[2];
#pragma unroll
  for (int ks = 0; ks < 2; ++ks) {
    bw[ks] = *(const bf16x8*)((const bf16_t*)(ws + OFF_WW2) + ((size_t)(dir * 512 + gc)) * 64 + ks * 32 + (lane >> 4) * 8);
    ba[ks] = *(const bf16x8*)((const bf16_t*)(ws + OFF_WA2) + ((size_t)(dir * 512 + gc)) * 64 + ks * 32 + (lane >> 4) * 8);
  }
  const float w0v = p.rw_w0[dir * 512 + gc], a0v = p.rw_a0[dir * 512 + gc], kkv = p.rw_k_k[gc], kav = p.rw_k_a[gc];
  const int tokb = b * SEQ;
  auto tok_of = [&](int ci, int tau) -> int { const int t = ci * 16 + tau; return tokb + (dir ? (SEQ - 1 - t) : t); };
  bf16x8 ta[2], za[2]; unsigned short kr[4], rr[4], vr[4]; float kiv[4];
  auto prep_load = [&](int ci) {
    const int tk = tok_of(ci, lane & 15);
#pragma unroll
    for (int ks = 0; ks < 2; ++ks) {
      ta[ks] = *(const bf16x8*)(TW + (size_t)tk * 128 + dir * 64 + ks * 32 + (lane >> 4) * 8);
      za[ks] = *(const bf16x8*)(ZA + (size_t)tk * 128 + dir * 64 + ks * 32 + (lane >> 4) * 8);
    }
#pragma unroll
    for (int j = 0; j < 4; ++j) {
      const int t2 = tok_of(ci, (lane >> 4) * 4 + j);
      kr[j] = K[(size_t)t2 * 512 + gc]; rr[j] = R[(size_t)t2 * 512 + gc]; vr[j] = V[(size_t)t2 * 512 + gc]; kiv[j] = kinv[(size_t)t2 * 8 + h];
    }
  };
  auto prep_finish = [&](int stage) {
    f32x4 aw = (f32x4){0.f, 0.f, 0.f, 0.f}, aa = aw;
    aw = __builtin_amdgcn_mfma_f32_16x16x32_bf16(ta[0], bw[0], aw, 0, 0, 0); aw = __builtin_amdgcn_mfma_f32_16x16x32_bf16(ta[1], bw[1], aw, 0, 0, 0);
    aa = __builtin_amdgcn_mfma_f32_16x16x32_bf16(za[0], ba[0], aa, 0, 0, 0); aa = __builtin_amdgcn_mfma_f32_16x16x32_bf16(za[1], ba[1], aa, 0, 0, 0);
#pragma unroll
    for (int j = 0; j < 4; ++j) {
      const int tau = (lane >> 4) * 4 + j;
      const float kval = bf2f(kr[j]), rval = bf2f(rr[j]), vval = bf2f(vr[j]);
      const float u = w0v + aw[j];
      const float z = -u, sp = fmaxf(z, 0.f) + __logf(1.f + __expf(-fabsf(z)));
      const float dec = __expf(-__expf(-sp - 0.5f));
      const float alr = 1.f / (1.f + __expf(-(a0v + aa[j])));
      const float kkn = kval * kkv * kiv[j];
      float* ob = opbuf + stage * 6144 + tau * 384 + n;
      ob[0] = -kkn; ob[64] = dec; ob[128] = kkn * alr; ob[192] = kval * (1.f + (alr - 1.f) * kav); ob[256] = rval; ob[320] = vval;
    }
  };
  float S0[8], S1[8];
#pragma unroll
  for (int c = 0; c < 8; ++c) { S0[c] = 0.f; S1[c] = 0.f; }
  const int cq = lane & 7, rp = lane >> 3, irow = w * 16 + 2 * rp;
  struct Ops { f32x4 a0, a1, w0, w1, b0, b1, k0, k1, r0, r1; f32x2 v; };
  auto load_ops = [&](Ops& o, const float* obase, int tau) {
    const float* ob = obase + tau * 384 + cq * 8;
    o.a0 = *(const f32x4*)(ob); o.a1 = *(const f32x4*)(ob + 4);
    o.v = *(const f32x2*)(obase + tau * 384 + 320 + irow);
    o.w0 = *(const f32x4*)(ob + 64); o.w1 = *(const f32x4*)(ob + 68);
    o.b0 = *(const f32x4*)(ob + 128); o.b1 = *(const f32x4*)(ob + 132);
    o.k0 = *(const f32x4*)(ob + 192); o.k1 = *(const f32x4*)(ob + 196);
    o.r0 = *(const f32x4*)(ob + 256); o.r1 = *(const f32x4*)(ob + 260);
  };
  auto red8 = [&](float x) -> float { x += dppf<0xB1>(x); x += dppf<0x4E>(x); x += dppf<0x141>(x); return x; };
  auto step = [&](const Ops& o, int tau) {
    float A[8], W[8], Bv[8], Kv[8], Rv[8];
#pragma unroll
    for (int e = 0; e < 4; ++e) { A[e] = o.a0[e]; A[4 + e] = o.a1[e]; W[e] = o.w0[e]; W[4 + e] = o.w1[e]; Bv[e] = o.b0[e]; Bv[4 + e] = o.b1[e];
      Kv[e] = o.k0[e]; Kv[4 + e] = o.k1[e]; Rv[e] = o.r0[e]; Rv[4 + e] = o.r1[e]; }
    float sa0 = mul_s(S0[0], A[0]), sa1 = mul_s(S1[0], A[0]);
#pragma unroll
    for (int c = 1; c < 8; ++c) { sa0 = fma_s(S0[c], A[c], sa0); sa1 = fma_s(S1[c], A[c], sa1); }
    float t0[8], t1[8];
#pragma unroll
    for (int c = 0; c < 8; ++c) { t0[c] = mul_s(o.v[0], Kv[c]); t1[c] = mul_s(o.v[1], Kv[c]); }
    sa0 = red8(sa0); sa1 = red8(sa1);
    float y0 = 0.f, y1 = 0.f;
#pragma unroll
    for (int c = 0; c < 8; ++c) {
      S0[c] = fma_s(S0[c], W[c], fma_s(sa0, Bv[c], t0[c]));
      S1[c] = fma_s(S1[c], W[c], fma_s(sa1, Bv[c], t1[c]));
      y0 = fma_s(S0[c], Rv[c], y0); y1 = fma_s(S1[c], Rv[c], y1);
    }
    y0 = red8(y0); y1 = red8(y1);
    if (cq == 0) *(f32x2*)(ybuf + tau * 16 + 2 * rp) = (f32x2){y0, y1};
  };
  prep_load(0); prep_finish(0); prep_load(1);
  __syncthreads();
  for (int ci = 0; ci < SEQ / 16; ++ci) {
    const bool more = ci + 1 < SEQ / 16;
    if (half == 1 && more) { prep_finish((ci + 1) & 1); if (ci + 2 < SEQ / 16) prep_load(ci + 2); }
    const float* obase = opbuf + (ci & 1) * 6144;
    Ops oa, ob2;
    load_ops(oa, obase, 0);
    for (int tau = 0; tau < 16; tau += 2) {
      load_ops(ob2, obase, tau + 1);
      __builtin_amdgcn_sched_barrier(0);
      step(oa, tau);
      __builtin_amdgcn_sched_barrier(0);
      if (tau + 2 < 16) load_ops(oa, obase, tau + 2);
      __builtin_amdgcn_sched_barrier(0);
      step(ob2, tau + 1);
      __builtin_amdgcn_sched_barrier(0);
    }
    {
      const int tau = lane >> 2, r4 = (lane & 3) * 4;
      const f32x4 yv = *(const f32x4*)(ybuf + tau * 16 + r4);
      *(u32x2*)(Y + (size_t)tok_of(ci, tau) * 512 + h * 64 + w * 16 + r4) = (u32x2){pk2(yv[0], yv[1]), pk2(yv[2], yv[3])};
    }
    if (half == 0 && more) { prep_finish((ci + 1) & 1); if (ci + 2 < SEQ / 16) prep_load(ci + 2); }
    __syncthreads();
  }
}

constexpr int KROW = 208, VROW = 136, KT_BYTES = 64 * KROW, VT_BYTES = 64 * VROW, ATT_STAGE = KT_BYTES + VT_BYTES;
DI int crow16(int i, int hh) { return (i & 3) + 8 * (i >> 2) + 4 * hh; }
DI void attn_item(const Params& p, int item, char* smem) {
  char* ws = launder(p.ws);
  const int qb = item & 7, bh = item >> 3, b = bh >> 3, h = bh & 7;
  const int tid = tidx(), lane = tid & 63, w = tid >> 6, l31 = lane & 31, hh = lane >> 5;
  const bf16_t* Q = (const bf16_t*)(ws + OFF_Q) + ((size_t)bh * SEQ + qb * 256 + w * 32 + l31) * 96;
  const bf16_t* Kn = (const bf16_t*)(ws + OFF_KN) + (size_t)bh * SEQ * 64;
  const bf16_t* Kpe = (const bf16_t*)(ws + OFF_KPE) + (size_t)b * SEQ * 32;
  const bf16_t* VT = (const bf16_t*)(ws + OFF_VT) + (size_t)bh * 64 * SEQ;
  bf16x8 qf[6];
#pragma unroll
  for (int ks = 0; ks < 6; ++ks) qf[ks] = *(const bf16x8*)(Q + ks * 16 + hh * 8);
  u32x4 kreg[2], vreg[1];
  auto gload = [&](int kt) {
    const int k0 = kt * 64;
#pragma unroll
    for (int i = 0; i < 2; ++i) { const int cid = tid + 512 * i, key = cid / 12, c = cid % 12;
      if (cid < 768) kreg[i] = (c < 8) ? *(const u32x4*)(Kn + (size_t)(k0 + key) * 64 + c * 8) : *(const u32x4*)(Kpe + (size_t)(k0 + key) * 32 + (c - 8) * 8); }
#pragma unroll
    for (int i = 0; i < 1; ++i) { const int cid = tid, dv = cid >> 3, c = cid & 7; vreg[i] = *(const u32x4*)(VT + (size_t)dv * SEQ + k0 + c * 8); }
  };
  auto lstore = [&](int stage) {
    char* st = smem + stage * ATT_STAGE;
#pragma unroll
    for (int i = 0; i < 2; ++i) { const int cid = tid + 512 * i, key = cid / 12, c = cid % 12; if (cid < 768) *(u32x4*)(st + key * KROW + c * 16) = kreg[i]; }
#pragma unroll
    for (int i = 0; i < 1; ++i) { const int cid = tid, dv = cid >> 3, c = cid & 7; char* d = st + KT_BYTES + dv * VROW + c * 16;
      *(u32x2*)d = (u32x2){vreg[i][0], vreg[i][1]}; *(u32x2*)(d + 8) = (u32x2){vreg[i][2], vreg[i][3]}; }
  };
  f32x16 o0, o1;
#pragma unroll
  for (int i = 0; i < 16; ++i) { o0[i] = 0.f; o1[i] = 0.f; }
  float mrun = 0.f, lsum = 0.f;
  f32x16 negm;
#pragma unroll
  for (int i = 0; i < 16; ++i) negm[i] = 0.f;
  gload(0); lstore(0);
  __syncthreads();
  for (int kt = 0; kt < SEQ / 64; ++kt) {
    const bool more = kt + 1 < SEQ / 64;
    if (more) gload(kt + 1);
    __builtin_amdgcn_sched_barrier(0);
    const char* st = smem + (kt & 1) * ATT_STAGE;
    f32x16 s0 = negm, s1 = negm;
#pragma unroll
    for (int ks = 0; ks < 6; ++ks) {
      const bf16x8 k0f = *(const bf16x8*)(st + l31 * KROW + ks * 32 + hh * 16);
      const bf16x8 k1f = *(const bf16x8*)(st + (32 + l31) * KROW + ks * 32 + hh * 16);
      s0 = __builtin_amdgcn_mfma_f32_32x32x16_bf16(k0f, qf[ks], s0, 0, 0, 0);
      s1 = __builtin_amdgcn_mfma_f32_32x32x16_bf16(k1f, qf[ks], s1, 0, 0, 0);
    }
    float mx = fmaxf(s0[0], s1[0]);
#pragma unroll
    for (int i = 1; i < 16; ++i) mx = fmaxf(mx, fmaxf(s0[i], s1[i]));
    mx = fmaxf(mx, __shfl_xor(mx, 32));
    if (kt == 0 || __any(mx > 8.f)) {
      const float alpha = __builtin_amdgcn_exp2f(-mx);
      mrun += mx; lsum *= alpha;
#pragma unroll
      for (int i = 0; i < 16; ++i) { s0[i] -= mx; s1[i] -= mx; o0[i] *= alpha; o1[i] *= alpha; negm[i] = -mrun; }
    }
    float ps = 0.f;
#pragma unroll
    for (int i = 0; i < 16; ++i) { s0[i] = __builtin_amdgcn_exp2f(s0[i]); s1[i] = __builtin_amdgcn_exp2f(s1[i]); ps += s0[i] + s1[i]; }
    lsum += ps;
    const char* vt = st + KT_BYTES;
#pragma unroll
    for (int s4 = 0; s4 < 4; ++s4) {
      const int ss = s4 & 1;
      u32x4 pw;
      if (s4 < 2) pw = (u32x4){pk2(s0[8 * ss], s0[8 * ss + 1]), pk2(s0[8 * ss + 2], s0[8 * ss + 3]), pk2(s0[8 * ss + 4], s0[8 * ss + 5]), pk2(s0[8 * ss + 6], s0[8 * ss + 7])};
      else pw = (u32x4){pk2(s1[8 * ss], s1[8 * ss + 1]), pk2(s1[8 * ss + 2], s1[8 * ss + 3]), pk2(s1[8 * ss + 4], s1[8 * ss + 5]), pk2(s1[8 * ss + 6], s1[8 * ss + 7])};
      const bf16x8 pf = __builtin_bit_cast(bf16x8, pw);
      const int koff = (s4 * 16 + 4 * hh) * 2;
      const u32x2 a0 = *(const u32x2*)(vt + l31 * VROW + koff), a1 = *(const u32x2*)(vt + l31 * VROW + koff + 16);
      const u32x2 b0 = *(const u32x2*)(vt + (32 + l31) * VROW + koff), b1 = *(const u32x2*)(vt + (32 + l31) * VROW + koff + 16);
      const bf16x8 v0f = __builtin_bit_cast(bf16x8, ((u32x4){a0[0], a0[1], a1[0], a1[1]}));
      const bf16x8 v1f = __builtin_bit_cast(bf16x8, ((u32x4){b0[0], b0[1], b1[0], b1[1]}));
      o0 = __builtin_amdgcn_mfma_f32_32x32x16_bf16(v0f, pf, o0, 0, 0, 0);
      o1 = __builtin_amdgcn_mfma_f32_32x32x16_bf16(v1f, pf, o1, 0, 0, 0);
    }
    __builtin_amdgcn_sched_barrier(0);
    if (more) lstore((kt + 1) & 1);
    __syncthreads();
  }
  lsum += __shfl_xor(lsum, 32);
  const float inv = 1.f / lsum;
  bf16_t* O = (bf16_t*)(ws + OFF_YMLA) + ((size_t)b * SEQ + qb * 256 + w * 32 + l31) * 512 + h * 64;
#pragma unroll
  for (int g = 0; g < 4; ++g) {
    const int dv = 8 * g + 4 * hh;
    *(u32x2*)(O + dv) = (u32x2){pk2(o0[4 * g] * inv, o0[4 * g + 1] * inv), pk2(o0[4 * g + 2] * inv, o0[4 * g + 3] * inv)};
    *(u32x2*)(O + 32 + dv) = (u32x2){pk2(o1[4 * g] * inv, o1[4 * g + 1] * inv), pk2(o1[4 * g + 2] * inv, o1[4 * g + 3] * inv)};
  }
}

DI void phase5(const Params& p, char* smem) {
  char* ws = launder(p.ws);
  bf16_t* mixed = (bf16_t*)(ws + OFF_MIXED);
  const int lane = tidx() & 63, wid = tidx() >> 6;
  const int nT = (NTOK / 256) * 4;
  for (int t2 = 2 * blockIdx.x; t2 < 2 * nT; t2 += 2 * gridDim.x) {
    for (int pass = 0; pass < 2; ++pass) {
      const int t = t2 >> 1;
      const int m0 = (t >> 2) * 256, n0 = (t & 3) * 256;
      const int rb = m0 + (wid >> 2) * 128, cb = n0 + (wid & 3) * 64;
      const bf16_t* Aop = (const bf16_t*)(ws + (pass ? OFF_YMLA : OFF_YRW));
      const bf16_t* Wop = (const bf16_t*)(ws + (pass ? OFF_WBR2 : OFF_WBR1));
      const bf16_t* gate = (const bf16_t*)(ws + (pass ? OFF_GB : OFF_GA));
      f32x4 acc[MI][4];
      zero_acc(acc);
      gemm_tile_acc(acc, Aop, 512, Wop, 512, m0, n0, 512, smem);
#pragma unroll
      for (int mi = 0; mi < MI; ++mi) {
        int row_ = rb + mi * 16 + (lane & 15); asm volatile("" : "+v"(row_) :: "memory");
#pragma unroll
        for (int ni = 0; ni < 4; ++ni) {
          const size_t o = (size_t)row_ * DM + cb + ni * 16 + (lane >> 4) * 4;
          const u32x2 g = *(const u32x2*)(gate + o);
          f32x4 v = acc[mi][ni] * (f32x4){bflo(g[0]), bfhi(g[0]), bflo(g[1]), bfhi(g[1])};
          if (pass) { const u32x2 mm = *(const u32x2*)(mixed + o); v += (f32x4){bflo(mm[0]), bfhi(mm[0]), bflo(mm[1]), bfhi(mm[1])}; }
          *(u32x2*)(mixed + o) = (u32x2){pk2(v[0], v[1]), pk2(v[2], v[3])};
        }
      }
    }
  }
}

template <bool WITH_H>
DI void ln_phase(const float* in, float* outp, const float* __restrict__ g, const float* __restrict__ be, const float* mod, bf16_t* hout) {
  const int lane = tidx() & 63, wid = tidx() >> 6;
  constexpr int R = 4;
  for (int rb = (blockIdx.x * 8 + wid) * R; rb < NTOK; rb += gridDim.x * 8 * R) {
    f32x4 v[R][4]; float s[R], q[R];
#pragma unroll
    for (int r = 0; r < R; ++r)
#pragma unroll
      for (int i = 0; i < 4; ++i) v[r][i] = *(const f32x4*)(in + (size_t)(rb + r) * DM + i * 256 + lane * 4);
#pragma unroll
    for (int r = 0; r < R; ++r) { s[r] = 0.f;
#pragma unroll
      for (int i = 0; i < 4; ++i) s[r] += (v[r][i][0] + v[r][i][1]) + (v[r][i][2] + v[r][i][3]); }
#pragma unroll
    for (int m = 1; m < 64; m <<= 1)
#pragma unroll
      for (int r = 0; r < R; ++r) s[r] += __shfl_xor(s[r], m);
#pragma unroll
    for (int r = 0; r < R; ++r) { const float mean = s[r] * (1.f / 1024.f); s[r] = mean; q[r] = 0.f;
#pragma unroll
      for (int i = 0; i < 4; ++i) { const f32x4 d = v[r][i] - mean; q[r] += (d[0] * d[0] + d[1] * d[1]) + (d[2] * d[2] + d[3] * d[3]); } }
#pragma unroll
    for (int m = 1; m < 64; m <<= 1)
#pragma unroll
      for (int r = 0; r < R; ++r) q[r] += __shfl_xor(q[r], m);
    const int b = rb / SEQ;
#pragma unroll
    for (int r = 0; r < R; ++r) {
      const int row = rb + r;
      const float mean = s[r], rstd = rsqrtf(q[r] * (1.f / 1024.f) + 1e-5f);
      if (WITH_H && lane == 0) *(f32x2*)(outp + (size_t)row * 2) = (f32x2){mean, rstd};
#pragma unroll
      for (int i = 0; i < 4; ++i) {
        const int col = i * 256 + lane * 4;
        const f32x4 o = (v[r][i] - mean) * rstd * *(const f32x4*)(g + col) + *(const f32x4*)(be + col);
        if (!WITH_H) *(f32x4*)(outp + (size_t)row * DM + col) = o;
        if (WITH_H) {
          const f32x4 sh = *(const f32x4*)(mod + b * 6144 + 3072 + col), sc = *(const f32x4*)(mod + b * 6144 + 4096 + col) + 1.f;
          const f32x4 hv = o * sc + sh;
          *(u32x2*)(hout + (size_t)row * DM + col) = (u32x2){pk2(hv[0], hv[1]), pk2(hv[2], hv[3])};
        }
      }
    }
  }
}

DI void gsync(unsigned* bar, unsigned& target) {
  asm volatile("s_waitcnt vmcnt(0) lgkmcnt(0)" ::: "memory");
  __syncthreads();
  target += gridDim.x;
  if (tidx() == 0) {
    __builtin_amdgcn_fence(__ATOMIC_RELEASE, "agent");
    asm volatile("s_waitcnt vmcnt(0)" ::: "memory");
    __hip_atomic_fetch_add(bar, 1u, __ATOMIC_RELAXED, __HIP_MEMORY_SCOPE_AGENT);
    while (__hip_atomic_load(bar, __ATOMIC_RELAXED, __HIP_MEMORY_SCOPE_AGENT) < target) __builtin_amdgcn_s_sleep(4);
    __builtin_amdgcn_fence(__ATOMIC_ACQUIRE, "agent");
    asm volatile("s_waitcnt vmcnt(0)" ::: "memory");
  }
  __syncthreads();
}

__global__ void __launch_bounds__(512, 2) fwd_mega(Params p) {
  __shared__ __attribute__((aligned(16))) char smem[131072];
  cg::grid_group grid = cg::this_grid();
  char* ws = launder(p.ws);
  unsigned* bar = (unsigned*)p.ws; unsigned target = 0;
  phase0a(p, smem);
  grid.sync();
  phase0b(p, smem);
  gsync(bar, target);
  ws = launder(ws);
  { InElem e{ws}; pg8_gemm8(smem, (const bf16_t*)(ws + OFF_HBF), (const bf16_t*)(ws + OFF_WIN), NTOK, DIN_PAD, DM, e); }
  gsync(bar, target);
  phase2(p);
  gsync(bar, target);
  ws = launder(ws);
  { EpiQ e{ws}; gemm_phase((const bf16_t*)(ws + OFF_ZQ), 384, (const bf16_t*)(ws + OFF_WUQ), 384, NTOK, 768, 384, smem, e); }
  ws = launder(ws);
  { EpiKV e{ws}; gemm_phase((const bf16_t*)(ws + OFF_ZKV), 256, (const bf16_t*)(ws + OFF_WUKV), 256, NTOK, 1024, 256, smem, e); }
  gsync(bar, target);
  for (int it = blockIdx.x; it < 256; it += gridDim.x) scan_item(p, it, smem);
  for (int it = blockIdx.x; it < 2048; it += gridDim.x) attn_item(p, it, smem);
  gsync(bar, target);
  ws = launder(ws);
  { EpiG8 e{ws, p.rw_lnx_g, p.rw_lnx_b}; gemm_phase<EpiG8, true>((const bf16_t*)(ws + OFF_SG), 128, (const bf16_t*)(ws + OFF_WG2), 128, NTOK, 512, 128, smem, e); }
  gsync(bar, target);
  ws = launder(ws);
  { MixElem e{(const bf16_t*)(ws + OFF_GA), (bf16_t*)(ws + OFF_MIXED), 0}; pg8_gemm8(smem, (const bf16_t*)(ws + OFF_YRW), (const bf16_t*)(ws + OFF_WBR1), NTOK, DM, 512, e); }
  ws = launder(ws);
  { MixElem e{(const bf16_t*)(ws + OFF_GB), (bf16_t*)(ws + OFF_MIXED), 1}; pg8_gemm8(smem, (const bf16_t*)(ws + OFF_YMLA), (const bf16_t*)(ws + OFF_WBR2), NTOK, DM, 512, e); }
  gsync(bar, target);
  ws = launder(ws);
  { ResElem e{p.x, (const float*)(ws + OFF_MOD) + 2048, (float*)(ws + OFF_T1)}; pg8_gemm(smem, (const bf16_t*)(ws + OFF_MIXED), (const bf16_t*)(ws + OFF_WOUT), NTOK, DM, DM, e); }
  gsync(bar, target);
  ws = launder(ws);
  ln_phase<true>((const float*)(ws + OFF_T1), (float*)(ws + OFF_RSQ), p.ln1_g, p.ln1_b, (const float*)(ws + OFF_MOD), (bf16_t*)(ws + OFF_HBF));
  gsync(bar, target);
  ws = launder(ws);
  { Relu2Elem e{(bf16_t*)(ws + OFF_HID)}; pg8_gemm8(smem, (const bf16_t*)(ws + OFF_HBF), (const bf16_t*)(ws + OFF_WFF1), NTOK, DFF, DM, e); }
  gsync(bar, target);
  ws = launder(ws);
  { Res2Elem e{(const float*)(ws + OFF_T1), (const float*)(ws + OFF_RSQ), p.ln1_g, p.ln1_b, (const float*)(ws + OFF_MOD) + 5120, p.out}; pg8_gemm(smem, (const bf16_t*)(ws + OFF_HID), (const bf16_t*)(ws + OFF_WFF2), NTOK, DM, DFF, e); }
  gsync(bar, target);
  ln_phase<false>(p.out, p.out, p.ln2_g, p.ln2_b, nullptr, nullptr);
}

extern "C" void kernel_launch(void* const* d_in, const int* in_sizes, int n_in, void* d_out, int out_size, void* d_ws, size_t ws_size, hipStream_t stream) {
  static int grid_blocks = 0;
  if (!grid_blocks) {
    int dev = 0, cus = 0, per_cu = 0;
    hipGetDevice(&dev);
    hipDeviceGetAttribute(&cus, hipDeviceAttributeMultiprocessorCount, dev);
    hipOccupancyMaxActiveBlocksPerMultiprocessor(&per_cu, fwd_mega, 512, 0);
    if (per_cu > 1) per_cu = 1;
    if (per_cu < 1) per_cu = 1;
    grid_blocks = cus * per_cu;
  }
  Params p{};
  p.x = (const float*)d_in[0]; p.c = (const float*)d_in[1]; p.pos = (const int*)d_in[2];
  p.w_ada = (const float*)d_in[3]; p.b_ada = (const float*)d_in[4]; p.w_in = (const float*)d_in[5]; p.rw_conv = (const float*)d_in[6];
  p.rw_w0 = (const float*)d_in[7]; p.rw_w2 = (const float*)d_in[8]; p.rw_a0 = (const float*)d_in[9]; p.rw_a2 = (const float*)d_in[10];
  p.rw_k_k = (const float*)d_in[11]; p.rw_k_a = (const float*)d_in[12]; p.rw_r_k = (const float*)d_in[13]; p.rw_g2 = (const float*)d_in[14];
  p.rw_lnx_g = (const float*)d_in[15]; p.rw_lnx_b = (const float*)d_in[16]; p.q_norm_g = (const float*)d_in[17]; p.kv_norm_g = (const float*)d_in[18];
  p.w_uq = (const float*)d_in[19]; p.w_ukv = (const float*)d_in[20]; p.w_br_rwkv = (const float*)d_in[21]; p.w_br_mla = (const float*)d_in[22];
  p.w_out = (const float*)d_in[23]; p.ln1_g = (const float*)d_in[24]; p.ln1_b = (const float*)d_in[25]; p.w_ff1 = (const float*)d_in[26];
  p.w_ff2 = (const float*)d_in[27]; p.ln2_g = (const float*)d_in[28]; p.ln2_b = (const float*)d_in[29];
  p.out = (float*)d_out; p.ws = (char*)d_ws;
  hipMemsetAsync(d_ws, 0, 256, stream);
  void* args[] = {&p};
  hipError_t e = hipLaunchCooperativeKernel((void*)fwd_mega, dim3(grid_blocks), dim3(512), args, 0, stream);
  if (e != hipSuccess) fprintf(stderr, "cooperative launch failed: %s (grid %d)\n", hipGetErrorString(e), grid_blocks);
}
```

```cpp
#include <hip/hip_runtime.h>
#include <hip/hip_cooperative_groups.h>
#include <stdint.h>
#include <stdio.h>
namespace cg = cooperative_groups;

#define DI __device__ __forceinline__
typedef unsigned short bf16_t;
typedef short bf16x8 __attribute__((ext_vector_type(8)));
typedef float f32x2 __attribute__((ext_vector_type(2)));
typedef float f32x4 __attribute__((ext_vector_type(4)));
typedef float f32x16 __attribute__((ext_vector_type(16)));
typedef unsigned u32x2 __attribute__((ext_vector_type(2)));
typedef unsigned u32x4 __attribute__((ext_vector_type(4)));
typedef __bf16 bf16x2_t __attribute__((ext_vector_type(2)));

constexpr int NB = 32, SEQ = 2048, DM = 1024, NTOK = NB * SEQ;
constexpr int DIN = 4640, DIN_PAD = 4864, DFF = 4096;
constexpr int NTHR = 512;
constexpr float DN_ALPHA = 1.189207115002721f;
constexpr size_t MiB = 1u << 20;
constexpr size_t OFF_MOD = 1 * MiB, OFF_PART = 512 * MiB, OFF_WIN = 8 * MiB, OFF_WFF1 = 18 * MiB, OFF_WFF2 = 26 * MiB, OFF_WOUT = 34 * MiB,
                 OFF_WBR1 = 36 * MiB, OFF_WBR2 = 37 * MiB, OFF_WUQ = 38 * MiB, OFF_WUKV = 39 * MiB, OFF_WW2 = 40 * MiB, OFF_WA2 = 40 * MiB + 262144,
                 OFF_WG2 = 40 * MiB + 524288, OFF_RSQ = 41 * MiB, OFF_RSKV = 41 * MiB + 524288, OFF_KINV = 42 * MiB, OFF_RKDOT = 44 * MiB, OFF_CS = 46 * MiB;
constexpr size_t OFF_HBF = 56 * MiB, OFF_TW = 56 * MiB, OFF_ZA = 72 * MiB, OFF_SG = 88 * MiB, OFF_YF = 104 * MiB;
constexpr size_t OFF_ZRW = 184 * MiB, OFF_Q = 184 * MiB, OFF_KN = 280 * MiB, OFF_VT = 344 * MiB, OFF_MIXED = 184 * MiB, OFF_HID = 184 * MiB;
constexpr size_t OFF_ZQ = 424 * MiB, OFF_ZKV = 472 * MiB, OFF_ZKR = 504 * MiB, OFF_KPE = 508 * MiB, OFF_YB = 424 * MiB;
constexpr size_t OFF_GA = 512 * MiB, OFF_GB = 640 * MiB;
constexpr size_t OFF_R = 768 * MiB, OFF_K = 832 * MiB, OFF_V = 896 * MiB, OFF_YRW = 768 * MiB, OFF_YMLA = 960 * MiB, OFF_T1 = 768 * MiB;

struct Params {
  const float *x, *c; const int* pos;
  const float *w_ada, *b_ada, *w_in, *rw_conv, *rw_w0, *rw_w2, *rw_a0, *rw_a2, *rw_k_k, *rw_k_a, *rw_r_k, *rw_g2, *rw_lnx_g, *rw_lnx_b,
      *q_norm_g, *kv_norm_g, *w_uq, *w_ukv, *w_br_rwkv, *w_br_mla, *w_out, *ln1_g, *ln1_b, *w_ff1, *w_ff2, *ln2_g, *ln2_b;
  float* out; char* ws;
};

DI unsigned pk2(float lo, float hi) { f32x2 v = {lo, hi}; bf16x2_t b = __builtin_convertvector(v, bf16x2_t); return __builtin_bit_cast(unsigned, b); }
DI unsigned short f2bf(float f) { return (unsigned short)(pk2(f, 0.f) & 0xffffu); }
DI float bf2f(unsigned short b) { return __uint_as_float(((unsigned)b) << 16); }
DI float bflo(unsigned u) { return __uint_as_float(u << 16); }
DI float bfhi(unsigned u) { return __uint_as_float(u & 0xffff0000u); }
DI float sigm(float x) { return 1.f / (1.f + __expf(-x)); }
template <int CTRL> DI float dppf(float x) { return __int_as_float(__builtin_amdgcn_update_dpp(0, __float_as_int(x), CTRL, 0xf, 0xf, true)); }
DI int tidx() { int t = __builtin_amdgcn_workitem_id_x(); asm volatile("" : "+v"(t)); return t; }
DI char* launder(char* p) { asm volatile("" : "+s"(p)); return p; }
DI float fma_s(float a, float b, float c) { float d; asm("v_fma_f32 %0, %1, %2, %3" : "=v"(d) : "v"(a), "v"(b), "v"(c)); return d; }
DI float mul_s(float a, float b) { float d; asm("v_mul_f32 %0, %1, %2" : "=v"(d) : "v"(a), "v"(b)); return d; }
DI float quad_sum(float x) { x += dppf<0xB1>(x); x += dppf<0x4E>(x); return x; }

DI void mod_partial_item(const Params& p, int item, char* smem) {
  const int nt = item % 24, kc = item / 24, tid = tidx(), k0 = kc * 128;
  float* sc = (float*)smem;
  for (int i = 0; i < 8; ++i) { const int idx = tid + 512 * i, b = idx >> 7, kk = idx & 127; const float v = p.c[b * DM + k0 + kk]; sc[kk * 32 + b] = v / (1.f + __expf(-v)); }
  __syncthreads();
  float acc[32];
#pragma unroll
  for (int b = 0; b < 32; ++b) acc[b] = 0.f;
  const int n = nt * 256 + (tid & 255), kh = (tid >> 8) * 64;
#pragma unroll 8
  for (int kk = kh; kk < kh + 64; ++kk) {
    const float w = p.w_ada[(size_t)(k0 + kk) * 6144 + n];
    const f32x4* s4 = (const f32x4*)(sc + kk * 32);
#pragma unroll
    for (int q = 0; q < 8; ++q) { const f32x4 s = s4[q]; acc[4 * q] += w * s[0]; acc[4 * q + 1] += w * s[1]; acc[4 * q + 2] += w * s[2]; acc[4 * q + 3] += w * s[3]; }
  }
  float* part = (float*)(p.ws + OFF_PART) + (size_t)(kc * 2 + (tid >> 8)) * 32 * 6144;
#pragma unroll
  for (int b = 0; b < 32; ++b) part[b * 6144 + n] = acc[b];
  __syncthreads();
}

DI void transpose_tile(const float* __restrict__ src, int N, bf16_t* dst, int ldd, int kt, int nt, const float* __restrict__ rowscale, int Nvalid, char* smem) {
  float* tile = (float*)smem;
  const int tid = tidx(), k0 = kt * 64, n0 = nt * 64, nn = tid & 63;
#pragma unroll
  for (int i = 0; i < 8; ++i) {
    const int kk = i * 8 + (tid >> 6);
    float v = 0.f;
    if (n0 + nn < Nvalid) { v = src[(size_t)(k0 + kk) * N + n0 + nn]; if (rowscale) v *= rowscale[k0 + kk]; }
    tile[kk * 65 + nn] = v;
  }
  __syncthreads();
  const int n = tid >> 3, kc = (tid & 7) * 8;
  unsigned w[4];
#pragma unroll
  for (int j = 0; j < 4; ++j) w[j] = pk2(tile[(kc + 2 * j) * 65 + n], tile[(kc + 2 * j + 1) * 65 + n]);
  bf16_t* d = dst + (size_t)(n0 + n) * ldd + k0 + kc;
  *(u32x4*)d = (u32x4){w[0], w[1], w[2], w[3]};
  __syncthreads();
}

DI void conv_item(const float* __restrict__ src, int N, bf16_t* dst, int ldd, int nb, int kc, const float* __restrict__ rowscale, int Nvalid, int Npad) {
  const int n = nb * 512 + tidx(), k0 = kc * 8;
  if (n >= Npad) return;
  float v[8];
#pragma unroll
  for (int j = 0; j < 8; ++j) v[j] = (n < Nvalid) ? src[(size_t)(k0 + j) * N + n] : 0.f;
  if (rowscale) {
#pragma unroll
    for (int j = 0; j < 8; ++j) v[j] *= rowscale[k0 + j];
  }
  *(u32x4*)(dst + (size_t)n * ldd + k0) = (u32x4){pk2(v[0], v[1]), pk2(v[2], v[3]), pk2(v[4], v[5]), pk2(v[6], v[7])};
}
DI void phase0a(const Params& p, char* smem) {
  char* ws = launder(p.ws);
  constexpr int N_MOD = 192;
  constexpr int T_IN = 10 * 128, T_FF1 = 8 * 128, T_FF2 = 2 * 512, T_OUT = 2 * 128, T_BR = 2 * 64, T_UQ = 2 * 48, T_UKV = 2 * 32, T_L = 8, T_G2 = 16;
  constexpr int E0 = N_MOD, E1 = E0 + T_IN, E2 = E1 + T_FF1, E3 = E2 + T_FF2, E4 = E3 + T_OUT, E5 = E4 + T_BR, E6 = E5 + T_BR, E7 = E6 + T_UQ, E8 = E7 + T_UKV,
                E9 = E8 + 2 * T_L, E10 = E9 + 2 * T_L, E11 = E10 + T_G2;
  for (int it = blockIdx.x; it < E11; it += gridDim.x) {
    if (it < E0) mod_partial_item(p, it, smem);
    else if (it < E1) { const int t = it - E0; conv_item(p.w_in, DIN, (bf16_t*)(ws + OFF_WIN), 1024, t % 10, t / 10, nullptr, DIN, DIN_PAD); }
    else if (it < E2) { const int t = it - E1; conv_item(p.w_ff1, DFF, (bf16_t*)(ws + OFF_WFF1), 1024, t % 8, t / 8, nullptr, DFF, DFF); }
    else if (it < E3) { const int t = it - E2; conv_item(p.w_ff2, DM, (bf16_t*)(ws + OFF_WFF2), DFF, t % 2, t / 2, nullptr, DM, DM); }
    else if (it < E4) { const int t = it - E3; conv_item(p.w_out, DM, (bf16_t*)(ws + OFF_WOUT), DM, t % 2, t / 2, nullptr, DM, DM); }
    else if (it < E5) { const int t = it - E4; conv_item(p.w_br_rwkv, DM, (bf16_t*)(ws + OFF_WBR1), 512, t % 2, t / 2, nullptr, DM, DM); }
    else if (it < E6) { const int t = it - E5; conv_item(p.w_br_mla, DM, (bf16_t*)(ws + OFF_WBR2), 512, t % 2, t / 2, nullptr, DM, DM); }
    else if (it < E7) { const int t = it - E6; conv_item(p.w_uq, 768, (bf16_t*)(ws + OFF_WUQ), 384, t % 2, t / 2, p.q_norm_g, 768, 768); }
    else if (it < E8) { const int t = it - E7; conv_item(p.w_ukv, 1024, (bf16_t*)(ws + OFF_WUKV), 256, t % 2, t / 2, p.kv_norm_g, 1024, 1024); }
    else if (it < E9) { const int t = it - E8, d = t / 8; conv_item(p.rw_w2 + d * 64 * 512, 512, (bf16_t*)(ws + OFF_WW2) + d * 512 * 64, 64, 0, t % 8, nullptr, 512, 512); }
    else if (it < E10) { const int t = it - E9, d = t / 8; conv_item(p.rw_a2 + d * 64 * 512, 512, (bf16_t*)(ws + OFF_WA2) + d * 512 * 64, 64, 0, t % 8, nullptr, 512, 512); }
    else { const int t = it - E10; conv_item(p.rw_g2, 512, (bf16_t*)(ws + OFF_WG2), 128, 0, t, nullptr, 512, 512); }
  }
}

DI void phase0b(const Params& p, char* smem) {
  const float* part = (const float*)(p.ws + OFF_PART);
  float* mod = (float*)(p.ws + OFF_MOD);
  const int tid = tidx();
  for (int m = blockIdx.x; m < 192; m += gridDim.x) {
    const int b = m / 6, seg = m % 6, col = seg * 1024 + (tid & 255) * 4;
    f32x4 v = *(const f32x4*)(p.b_ada + col);
    for (int kc = 0; kc < 16; ++kc) v += *(const f32x4*)(part + ((size_t)kc * 32 + b) * 6144 + col);
    if (tid < 256) *(f32x4*)(mod + b * 6144 + col) = v;
  }
  bf16_t* hbf = (bf16_t*)(p.ws + OFF_HBF);
  for (int t = blockIdx.x; t < NTOK / 128; t += gridDim.x) {
    const int row0 = t * 128, b = row0 / SEQ, col = (tid & 255) * 4;
    f32x4 sh = *(const f32x4*)(p.b_ada + col), sc = *(const f32x4*)(p.b_ada + 1024 + col);
    for (int kc = 0; kc < 16; ++kc) { const float* pp = part + ((size_t)kc * 32 + b) * 6144 + col; sh += *(const f32x4*)pp; sc += *(const f32x4*)(pp + 1024); }
    sc += 1.f;
#pragma unroll 8
    for (int r = tid >> 8; r < 128; r += 2) {
      const f32x4 xv = *(const f32x4*)(p.x + (size_t)(row0 + r) * DM + col);
      const f32x4 h = xv * sc + sh;
      *(u32x2*)(hbf + (size_t)(row0 + r) * DM + col) = (u32x2){pk2(h[0], h[1]), pk2(h[2], h[3])};
    }
  }
}

typedef __attribute__((address_space(3))) unsigned lds_u32_t;
DI void dma16(const void* g, char* l) { __builtin_amdgcn_global_load_lds((const unsigned*)g, (lds_u32_t*)l, 16, 0, 0); }
constexpr int MI = 8;
constexpr int GSTAGE = 32768;
template <bool PERMB = false>
DI void gemm_tile_acc(f32x4 (&acc)[MI][4], const bf16_t* A, int lda, const bf16_t* Bt, int ldb, int m0, int n0, int K, char* smem) {
  const int tid = tidx(), lane = tid & 63, wid = __builtin_amdgcn_readfirstlane(tid >> 6), wm = wid >> 2, wn = wid & 3;
  const int lr = lane >> 2, lch = (lane & 3) ^ ((lane >> 3) & 3);
  const bf16_t* Ag = A + (size_t)(m0 + wid * 32 + lr) * lda + lch * 8;
  const int brow = PERMB ? (8 * (lr >> 2) + (lr & 3)) : lr, bstep = PERMB ? 4 : 16;
  const bf16_t* Bg = Bt + (size_t)(n0 + wid * 32 + brow) * ldb + lch * 8;
  const int nk = K >> 5;
  const int fch = ((lane >> 4) ^ ((lane >> 1) & 3)) << 4;
  const int abase = (wm * 128 + (lane & 15)) * 64 + fch, bbase = 16384 + (wn * 64 + (lane & 15)) * 64 + fch;
  char* swa = smem + wid * 2048;
  char* swb = smem + 16384 + wid * 2048;
#define GEMM_ISSUE(kt_, st_) do { char* da_ = swa + (st_) * GSTAGE; char* db_ = swb + (st_) * GSTAGE; \
    _Pragma("unroll") for (int i_ = 0; i_ < 2; ++i_) dma16(Ag + (size_t)i_ * 16 * lda + (kt_) * 32, da_ + i_ * 1024); \
    _Pragma("unroll") for (int i_ = 0; i_ < 2; ++i_) dma16(Bg + (size_t)i_ * bstep * ldb + (kt_) * 32, db_ + i_ * 1024); } while (0)
  GEMM_ISSUE(0, 0);
  if (nk > 1) GEMM_ISSUE(1, 1);
  int st = 0, st2 = 2;
  for (int kt = 0; kt < nk; ++kt) {
    if (kt + 1 < nk) asm volatile("s_waitcnt vmcnt(4)" ::: "memory"); else asm volatile("s_waitcnt vmcnt(0)" ::: "memory");
    __builtin_amdgcn_s_barrier();
    asm volatile("" ::: "memory");
    const bool issue = kt + 2 < nk;
    char* da = swa + st2 * GSTAGE; char* db = swb + st2 * GSTAGE;
    const bf16_t* ga_ = Ag + (kt + 2) * 32; const bf16_t* gb_ = Bg + (kt + 2) * 32;
    const char* sp = smem + st * GSTAGE;
    bf16x8 bfr[4];
#pragma unroll
    for (int i = 0; i < 4; ++i) bfr[i] = *(const bf16x8*)(sp + bbase + i * 1024);
#pragma unroll
    for (int hf = 0; hf < 2; ++hf) {
      bf16x8 af[4];
#pragma unroll
      for (int i = 0; i < 4; ++i) af[i] = *(const bf16x8*)(sp + abase + (hf * 4 + i) * 1024);
#pragma unroll
      for (int mi = 0; mi < 4; ++mi) {
#pragma unroll
        for (int ni = 0; ni < 4; ++ni) acc[hf * 4 + mi][ni] = __builtin_amdgcn_mfma_f32_16x16x32_bf16(bfr[ni], af[mi], acc[hf * 4 + mi][ni], 0, 0, 0);
        const int pc = hf * 4 + mi;
        if (issue) { if (pc == 0 || pc == 2) dma16(ga_ + (size_t)(pc >> 1) * 16 * lda, da + (pc >> 1) * 1024); else if (pc == 4 || pc == 6) dma16(gb_ + (size_t)((pc - 4) >> 1) * bstep * ldb, db + ((pc - 4) >> 1) * 1024); }
      }
    }
    st = (st == 2) ? 0 : st + 1; st2 = (st2 == 2) ? 0 : st2 + 1;
  }
  asm volatile("s_waitcnt lgkmcnt(0)" ::: "memory");
  __builtin_amdgcn_s_barrier();
  asm volatile("" ::: "memory");
#undef GEMM_ISSUE
}
DI void zero_acc(f32x4 (&acc)[MI][4]) {
#pragma unroll
  for (int i = 0; i < MI; ++i)
#pragma unroll
    for (int j = 0; j < 4; ++j) acc[i][j] = (f32x4){0.f, 0.f, 0.f, 0.f};
}

template <class Epi, bool PERMB = false>
DI void gemm_phase(const bf16_t* A, int lda, const bf16_t* Bt, int ldb, int M, int N, int K, char* smem, const Epi& epi) {
  const int nN = N / 256, nT = (M / 256) * nN;
  const int lane = tidx() & 63, wid = tidx() >> 6;
  const int xg = blockIdx.x & 7, jg = blockIdx.x >> 3, per = gridDim.x >> 3;
  for (int t0 = 0; t0 < nT; t0 += gridDim.x) {
    int t = t0 + xg * per + jg;
    if (nN == 16 && gridDim.x == 256) { const int tmr = (xg >> 1) * 4 + (jg >> 3), tnr = (xg & 1) * 8 + (jg & 7); t = t0 + tmr * 16 + tnr; }
    if (t >= nT) continue;
    const int m0 = (t / nN) * 256, n0 = (t % nN) * 256;
    f32x4 acc[MI][4];
    zero_acc(acc);
    gemm_tile_acc<PERMB>(acc, A, lda, Bt, ldb, m0, n0, K, smem);
    epi(acc, m0 + (wid >> 2) * 128, n0 + (wid & 3) * 64, lane);
  }
}

struct EpiIn {
  char* ws;
  DI void operator()(f32x4 (&acc)[MI][4], int rb, int cb, int lane) const {
    bf16_t *zrw = (bf16_t*)(ws + OFF_ZRW), *zq = (bf16_t*)(ws + OFF_ZQ), *zkv = (bf16_t*)(ws + OFF_ZKV), *zkr = (bf16_t*)(ws + OFF_ZKR), *ga = (bf16_t*)(ws + OFF_GA), *gb = (bf16_t*)(ws + OFF_GB);
#pragma unroll
    for (int ni = 0; ni < 4; ++ni) {
      const int col = cb + ni * 16 + (lane >> 4) * 4;
      if (col >= DIN) continue;
#pragma unroll
      for (int mi = 0; mi < MI; ++mi) {
        int row_ = rb + mi * 16 + (lane & 15); asm volatile("" : "+v"(row_));
        const size_t row = row_;
        f32x4 v = acc[mi][ni];
        bf16_t* d;
        if (col < 1920) d = zrw + row * 1920 + col;
        else if (col < 2304) d = zq + row * 384 + (col - 1920);
        else if (col < 2560) d = zkv + row * 256 + (col - 2304);
        else if (col < 2592) d = zkr + row * 32 + (col - 2560);
        else {
          v = (f32x4){sigm(v[0]), sigm(v[1]), sigm(v[2]), sigm(v[3])};
          d = (col < 3616) ? ga + row * 1024 + (col - 2592) : gb + row * 1024 + (col - 3616);
        }
        *(u32x2*)d = (u32x2){pk2(v[0], v[1]), pk2(v[2], v[3])};
      }
    }
  }
};

constexpr float QSCALE = 0.10206207261596577f * 1.4426950408889634f;
struct EpiQ {
  char* ws;
  DI void operator()(f32x4 (&acc)[MI][4], int rb, int cb, int lane) const {
    bf16_t* Q = (bf16_t*)(ws + OFF_Q); const float* rsq = (const float*)(ws + OFF_RSQ); const float* cs = (const float*)(ws + OFF_CS);
#pragma unroll
    for (int mi = 0; mi < MI; ++mi) {
      int row = rb + mi * 16 + (lane & 15); asm volatile("" : "+v"(row) :: "memory");
      const int b = row / SEQ, s = row % SEQ;
      const float rs = rsq[row] * QSCALE;
#pragma unroll
      for (int ni = 0; ni < 4; ++ni) {
        const int nt = (cb >> 4) + ni, h = nt / 6, sub = nt % 6;
        bf16_t* d = Q + ((size_t)(b * 8 + h) * SEQ + s) * 96;
        const int c4 = (lane >> 4) * 4;
        if (sub < 4) { const f32x4 v = acc[mi][ni] * rs; *(u32x2*)(d + sub * 16 + c4) = (u32x2){pk2(v[0], v[1]), pk2(v[2], v[3])}; }
        else if (sub == 4) {
          if (ni < 3) {
            const f32x4 x1 = acc[mi][ni] * rs, x2 = acc[mi][ni + 1 < 4 ? ni + 1 : 3] * rs;
            const f32x4 co = *(const f32x4*)(cs + (size_t)row * 32 + c4), si = *(const f32x4*)(cs + (size_t)row * 32 + 16 + c4);
            const f32x4 o1 = x1 * co - x2 * si, o2 = x1 * si + x2 * co;
            *(u32x2*)(d + 64 + c4) = (u32x2){pk2(o1[0], o1[1]), pk2(o1[2], o1[3])};
            *(u32x2*)(d + 80 + c4) = (u32x2){pk2(o2[0], o2[1]), pk2(o2[2], o2[3])};
          }
        }
      }
    }
  }
};
struct EpiKV {
  char* ws;
  DI void operator()(f32x4 (&acc)[MI][4], int rb, int cb, int lane) const {
    bf16_t* Kn = (bf16_t*)(ws + OFF_KN); bf16_t* VT = (bf16_t*)(ws + OFF_VT); const float* rskv = (const float*)(ws + OFF_RSKV);
    const int h = cb >> 7, isv = (cb >> 6) & 1;
#pragma unroll
    for (int mi = 0; mi < MI; ++mi) {
      int row = rb + mi * 16 + (lane & 15); asm volatile("" : "+v"(row) :: "memory");
      const int b = row / SEQ, s = row % SEQ;
      const float rs = rskv[row];
#pragma unroll
      for (int ni = 0; ni < 4; ++ni) {
        const int d0 = ni * 16 + (lane >> 4) * 4;
        const f32x4 v = acc[mi][ni] * rs;
        if (!isv) *(u32x2*)(Kn + ((size_t)(b * 8 + h) * SEQ + s) * 64 + d0) = (u32x2){pk2(v[0], v[1]), pk2(v[2], v[3])};
        else {
          bf16_t* d = VT + ((size_t)(b * 8 + h) * 64 + d0) * SEQ + s;
          d[0] = f2bf(v[0]); d[SEQ] = f2bf(v[1]); d[2 * SEQ] = f2bf(v[2]); d[3 * SEQ] = f2bf(v[3]);
        }
      }
    }
  }
};
struct EpiG {
  char* ws; const float *lnx_g, *lnx_b;
  DI void operator()(f32x4 (&acc)[MI][4], int rb, int cb, int lane) const {
    const bf16_t *yf = (const bf16_t*)(ws + OFF_YF), *yb = (const bf16_t*)(ws + OFF_YB), *V = (const bf16_t*)(ws + OFF_V);
    const float* rkdot = (const float*)(ws + OFF_RKDOT); bf16_t* yrw = (bf16_t*)(ws + OFF_YRW);
    const int h = cb >> 6;
#pragma unroll
    for (int mi = 0; mi < MI; ++mi) {
      int row_ = rb + mi * 16 + (lane & 15); asm volatile("" : "+v"(row_) :: "memory");
      const size_t row = row_;
      f32x4 y[4]; float sum = 0.f;
#pragma unroll
      for (int ni = 0; ni < 4; ++ni) {
        const size_t o = row * 512 + cb + ni * 16 + (lane >> 4) * 4;
        const u32x2 a = *(const u32x2*)(yf + o), b2 = *(const u32x2*)(yb + o);
        y[ni] = (f32x4){bflo(a[0]) + bflo(b2[0]), bfhi(a[0]) + bfhi(b2[0]), bflo(a[1]) + bflo(b2[1]), bfhi(a[1]) + bfhi(b2[1])};
        sum += (y[ni][0] + y[ni][1]) + (y[ni][2] + y[ni][3]);
      }
      sum += __shfl_xor(sum, 16); sum += __shfl_xor(sum, 32);
      const float mean = sum * (1.f / 64.f);
      float q = 0.f;
#pragma unroll
      for (int ni = 0; ni < 4; ++ni) { const f32x4 dd = y[ni] - mean; q += (dd[0] * dd[0] + dd[1] * dd[1]) + (dd[2] * dd[2] + dd[3] * dd[3]); }
      q += __shfl_xor(q, 16); q += __shfl_xor(q, 32);
      const float rstd = rsqrtf(q * (1.f / 64.f) + 64e-5f);
      const float rk = rkdot[row * 8 + h];
#pragma unroll
      for (int ni = 0; ni < 4; ++ni) {
        const int col = cb + ni * 16 + (lane >> 4) * 4;
        const f32x4 g = *(const f32x4*)(lnx_g + col), be = *(const f32x4*)(lnx_b + col);
        const u32x2 vv = *(const u32x2*)(V + row * 512 + col);
        const f32x4 vf = (f32x4){bflo(vv[0]), bfhi(vv[0]), bflo(vv[1]), bfhi(vv[1])};
        const f32x4 o = ((y[ni] - mean) * rstd * g + be + vf * rk) * acc[mi][ni];
        *(u32x2*)(yrw + row * 512 + col) = (u32x2){pk2(o[0], o[1]), pk2(o[2], o[3])};
      }
      asm volatile("" ::: "memory");
    }
  }
};
struct EpiG8 {
  char* ws; const float *lnx_g, *lnx_b;
  DI void operator()(f32x4 (&acc)[MI][4], int rb, int cb, int lane) const {
    const bf16_t *yf = (const bf16_t*)(ws + OFF_YF), *yb = (const bf16_t*)(ws + OFF_YB), *V = (const bf16_t*)(ws + OFF_V);
    const float* rkdot = (const float*)(ws + OFF_RKDOT); bf16_t* yrw = (bf16_t*)(ws + OFF_YRW);
    const int h = cb >> 6;
#pragma unroll
    for (int mi = 0; mi < MI; ++mi) {
      int row_ = rb + mi * 16 + (lane & 15); asm volatile("" : "+v"(row_));
      const size_t row = row_;
      f32x4 y[4]; float sum = 0.f;
      u32x4 vv2[2];
#pragma unroll
      for (int pr = 0; pr < 2; ++pr) vv2[pr] = *(const u32x4*)(V + row * 512 + cb + pr * 32 + (lane >> 4) * 8);
      const float rk = rkdot[row * 8 + h];
#pragma unroll
      for (int pr = 0; pr < 2; ++pr) {
        const size_t o = row * 512 + cb + pr * 32 + (lane >> 4) * 8;
        const u32x4 a = *(const u32x4*)(yf + o), b2 = *(const u32x4*)(yb + o);
        y[2 * pr] = (f32x4){bflo(a[0]) + bflo(b2[0]), bfhi(a[0]) + bfhi(b2[0]), bflo(a[1]) + bflo(b2[1]), bfhi(a[1]) + bfhi(b2[1])};
        y[2 * pr + 1] = (f32x4){bflo(a[2]) + bflo(b2[2]), bfhi(a[2]) + bfhi(b2[2]), bflo(a[3]) + bflo(b2[3]), bfhi(a[3]) + bfhi(b2[3])};
        sum += ((y[2 * pr][0] + y[2 * pr][1]) + (y[2 * pr][2] + y[2 * pr][3])) + ((y[2 * pr + 1][0] + y[2 * pr + 1][1]) + (y[2 * pr + 1][2] + y[2 * pr + 1][3]));
      }
      sum += __shfl_xor(sum, 16); sum += __shfl_xor(sum, 32);
      const float mean = sum * (1.f / 64.f);
      float q = 0.f;
#pragma unroll
      for (int ni = 0; ni < 4; ++ni) { const f32x4 dd = y[ni] - mean; q += (dd[0] * dd[0] + dd[1] * dd[1]) + (dd[2] * dd[2] + dd[3] * dd[3]); }
      q += __shfl_xor(q, 16); q += __shfl_xor(q, 32);
      const float rstd = rsqrtf(q * (1.f / 64.f) + 64e-5f);
#pragma unroll
      for (int pr = 0; pr < 2; ++pr) {
        const int col = cb + pr * 32 + (lane >> 4) * 8;
        const u32x4 vv = vv2[pr];
        const f32x4 g0 = *(const f32x4*)(lnx_g + col), g1 = *(const f32x4*)(lnx_g + col + 4), be0 = *(const f32x4*)(lnx_b + col), be1 = *(const f32x4*)(lnx_b + col + 4);
        const f32x4 v0 = (f32x4){bflo(vv[0]), bfhi(vv[0]), bflo(vv[1]), bfhi(vv[1])}, v1 = (f32x4){bflo(vv[2]), bfhi(vv[2]), bflo(vv[3]), bfhi(vv[3])};
        const f32x4 o0 = ((y[2 * pr] - mean) * rstd * g0 + be0 + v0 * rk) * acc[mi][2 * pr];
        const f32x4 o1 = ((y[2 * pr + 1] - mean) * rstd * g1 + be1 + v1 * rk) * acc[mi][2 * pr + 1];
        *(u32x4*)(yrw + row * 512 + col) = (u32x4){pk2(o0[0], o0[1]), pk2(o0[2], o0[3]), pk2(o1[0], o1[1]), pk2(o1[2], o1[3])};
      }
      if (mi & 1) asm volatile("" ::: "memory");
    }
  }
};
struct EpiRes {
  const float* base; const float* gate; float* out;
  DI void operator()(f32x4 (&acc)[MI][4], int rb, int cb, int lane) const {
#pragma unroll
    for (int mi = 0; mi < MI; ++mi) {
      int row_ = rb + mi * 16 + (lane & 15); asm volatile("" : "+v"(row_) :: "memory");
      const size_t row = row_; const int b = (int)(row / SEQ);
#pragma unroll
      for (int ni = 0; ni < 4; ++ni) {
        const int col = cb + ni * 16 + (lane >> 4) * 4;
        const f32x4 g = *(const f32x4*)(gate + b * 6144 + col) + 1.f;
        const f32x4 xb = *(const f32x4*)(base + row * DM + col);
        *(f32x4*)(out + row * DM + col) = xb * DN_ALPHA + g * acc[mi][ni];
      }
      asm volatile("" ::: "memory");
    }
  }
};
struct EpiRelu2 {
  bf16_t* out;
  DI void operator()(f32x4 (&acc)[MI][4], int rb, int cb, int lane) const {
#pragma unroll
    for (int mi = 0; mi < MI; ++mi) {
      int row_ = rb + mi * 16 + (lane & 15); asm volatile("" : "+v"(row_) :: "memory");
      const size_t row = row_;
#pragma unroll
      for (int ni = 0; ni < 4; ++ni) {
        const int col = cb + ni * 16 + (lane >> 4) * 4;
        f32x4 v = acc[mi][ni];
#pragma unroll
        for (int j = 0; j < 4; ++j) { const float r = fmaxf(v[j], 0.f); v[j] = r * r; }
        *(u32x2*)(out + row * DFF + col) = (u32x2){pk2(v[0], v[1]), pk2(v[2], v[3])};
      }
    }
  }
};

namespace pg8 {
#define PG8_LAS __attribute__((address_space(3)))
typedef unsigned short bf16_t;
typedef short bf16x8 __attribute__((ext_vector_type(8)));
typedef float f32x4 __attribute__((ext_vector_type(4)));
typedef unsigned u32x4 __attribute__((ext_vector_type(4)));
constexpr int BM = 256, BK = 64, HALF = 128, HTB = HALF * BK * 2  , STAGE_BYTES = 8 * HTB, NXCD = 8, WGM = 8;

__host__ __device__ __forceinline__ int lds_byte(int r, int c) { const int st = (r >> 4) * 2 + (c >> 5), rr = r & 15, cc = c & 31, ob = rr * 64 + cc * 2; return st * 1024 + (ob ^ (((ob >> 9) & 1) << 5)); }
__host__ __device__ __forceinline__ void stage_rc(int b, int& R, int& C) { const int st = b / 1024, sb = b % 1024, swz = sb ^ (((sb >> 9) & 1) << 5); R = (st >> 1) * 16 + swz / 64; C = (st & 1) * 32 + (swz % 64) / 2; }
__host__ __device__ __forceinline__ int perm32(int rho) { const int n = rho >> 4, i = rho & 15; return 8 * (i >> 2) + 4 * n + (i & 3); }

struct Unit { int pm, pn; };
struct Gemm { const bf16_t* A; const bf16_t* Bt; int M, N, K; };

struct StaticOrder {
    int nM, nN, nwg, G, c;
    __host__ __device__ void init(int M, int N, int G_, int c_) { nM = M / BM; nN = N / BM; nwg = nM * nN; G = G_; c = c_; }
    __host__ __device__ bool next(int i, Unit& u) const {
        const long L = (long)i * G + c; if (L >= nwg) return false;
        int wgid = (int)L; { const int q = nwg / NXCD, r = nwg % NXCD, xcd = wgid % NXCD, off = wgid / NXCD; wgid = (xcd < r ? xcd * (q + 1) : r * (q + 1) + (xcd - r) * q) + off; }
        const int nig = WGM * nN, gid = wgid / nig, fm = gid * WGM, gsz = (nM - fm) < WGM ? (nM - fm) : WGM;
        u.pm = fm + ((wgid % nig) % gsz); u.pn = (wgid % nig) / gsz; return true;
    }
    __device__ __forceinline__ void a_ready(const Unit&) const {}
    __device__ __forceinline__ void done(const Unit&) const {}
};

template <class Epi, class Sched, bool ALIGN_EPI = false, bool SP2 = false>
__device__ __forceinline__ void gemm_phase(PG8_LAS unsigned char* lds, const Gemm g, const Sched& S, const Epi& E) {
    const int tid = ::tidx(), wid = __builtin_amdgcn_readfirstlane(tid >> 6), lane = tid & 63, wr = wid >> 2, wc = wid & 3, fr = lane & 15, fq = lane >> 4;
    const int K = g.K, nt = K / BK;
    unsigned voffA[2], voffB[2];
#pragma unroll
    for (int i = 0; i < 2; ++i) { int R, C; stage_rc(tid * 16 + i * 8192, R, C); const int Rb = Epi::PERM ? ((R & ~31) + perm32(R & 31)) : R;
        voffA[i] = (unsigned)(R * K + C) * 2u; voffB[i] = (unsigned)(Rb * K + C) * 2u; }
    const size_t kstep = (size_t)(BK * 2);
    const size_t hstep = (size_t)HALF * K * 2;
    const size_t tstep = 2 * hstep;
    const unsigned ldsw = (unsigned)wid * 1024u;
    const int aoff = lds_byte(wr * 64 + fr, fq * 8), boff = lds_byte(wc * 32 + fr, fq * 8);
#define PG8_SA(b, h) (((b) * 2 + (h)) * HTB)
#define PG8_SB(b, h) ((4 + (b) * 2 + (h)) * HTB)
#define PG8_STAGE(bufoff, gbase, voff) do { _Pragma("unroll") for (int _i = 0; _i < 2; ++_i) \
        __builtin_amdgcn_global_load_lds((const unsigned*)((const char*)(gbase) + (voff)[_i]), (PG8_LAS unsigned*)(lds + (bufoff) + ldsw + _i * 8192), 16, 0, 0); } while (0)
#define PG8_LDA(dst, b, h) do { _Pragma("unroll") for (int m = 0; m < 4; ++m) _Pragma("unroll") for (int k = 0; k < 2; ++k) dst[m][k] = *(const PG8_LAS bf16x8*)(lds + PG8_SA(b, h) + aoff + m * 2048 + k * 1024); } while (0)
#define PG8_LDB(dst, b, h) do { _Pragma("unroll") for (int n = 0; n < 2; ++n) _Pragma("unroll") for (int k = 0; k < 2; ++k) dst[n][k] = *(const PG8_LAS bf16x8*)(lds + PG8_SB(b, h) + boff + n * 2048 + k * 1024); } while (0)
#define PG8_MMA(ai, bj, At, Bt) do { __builtin_amdgcn_s_setprio(1); _Pragma("unroll") for (int m = 0; m < 4; ++m) _Pragma("unroll") for (int n = 0; n < 2; ++n) _Pragma("unroll") for (int k = 0; k < 2; ++k) \
        acc[ai][bj][m][n] = __builtin_amdgcn_mfma_f32_16x16x32_bf16(Bt[n][k], At[m][k], acc[ai][bj][m][n], 0, 0, 0); __builtin_amdgcn_s_setprio(0); } while (0)
#define PG8_WAIT_V(n) asm volatile("s_waitcnt vmcnt(" #n ")" ::: "memory")
#define PG8_WAIT_L(n) asm volatile("s_waitcnt lgkmcnt(" #n ")" ::: "memory")
#define PG8_BAR __builtin_amdgcn_s_barrier()
#define PG8_SCHED __builtin_amdgcn_sched_barrier(0)
    Unit cur, nxt; int ui = 0;
    if (!S.next(0, cur)) return;
    f32x4 acc[2][2][4][2];
#pragma unroll
    for (int a = 0; a < 2; ++a)
#pragma unroll
        for (int b = 0; b < 2; ++b)
#pragma unroll
            for (int m = 0; m < 4; ++m)
#pragma unroll
                for (int n = 0; n < 2; ++n) acc[a][b][m][n] = (f32x4){0.f, 0.f, 0.f, 0.f};
    bf16x8 At[4][2], B0[2][2], B1[2][2];
    const char* cA = (const char*)g.A + (size_t)cur.pm * tstep; const char* cB = (const char*)g.Bt + (size_t)cur.pn * tstep;
    S.a_ready(cur);
    if constexpr (SP2) {
        PG8_STAGE(PG8_SB(0, 0), cB, voffB); PG8_STAGE(PG8_SB(0, 1), cB + hstep, voffB); PG8_STAGE(PG8_SA(0, 0), cA, voffA); PG8_STAGE(PG8_SA(0, 1), cA + hstep, voffA);
        if (wr == 1) PG8_BAR;
        PG8_WAIT_V(2); PG8_BAR;
        PG8_STAGE(PG8_SB(1, 0), cB + kstep, voffB); PG8_STAGE(PG8_SA(1, 0), cA + kstep, voffA); PG8_STAGE(PG8_SB(1, 1), cB + hstep + kstep, voffB);
        PG8_WAIT_V(6); PG8_BAR;
    } else {
        PG8_STAGE(PG8_SB(0, 0), cB, voffB); PG8_STAGE(PG8_SA(0, 0), cA, voffA); PG8_STAGE(PG8_SB(0, 1), cB + hstep, voffB); PG8_STAGE(PG8_SA(0, 1), cA + hstep, voffA);
        if (wr == 1) PG8_BAR;
        PG8_WAIT_V(4); PG8_BAR;
        PG8_STAGE(PG8_SB(1, 0), cB + kstep, voffB); PG8_STAGE(PG8_SA(1, 0), cA + kstep, voffA); PG8_STAGE(PG8_SB(1, 1), cB + hstep + kstep, voffB);
        PG8_WAIT_V(6); PG8_BAR;
    }
    for (;;) {
        const bool has_next = S.next(ui + 1, nxt);
        const char* nA = has_next ? (const char*)g.A + (size_t)nxt.pm * tstep : cA; const char* nB = has_next ? (const char*)g.Bt + (size_t)nxt.pn * tstep : cB;
        for (int t = 0; t < nt; t += 2) {
            const bool last = (t == nt - 2);
            const char* a1 = cA + (size_t)(t + 1) * kstep;
            const char* a2 = last ? nA : cA + (size_t)(t + 2) * kstep; const char* b2 = last ? nB : cB + (size_t)(t + 2) * kstep;
            const char* a3 = a2 + kstep; const char* b3 = b2 + kstep;
            if (last && has_next) S.a_ready(nxt);
            if constexpr (SP2) {
            PG8_LDB(B0, 0, 0); PG8_LDB(B1, 0, 1); PG8_SCHED; PG8_LDA(At, 0, 0); PG8_STAGE(PG8_SA(1, 1), a1 + hstep, voffA);
            PG8_WAIT_V(8); PG8_WAIT_L(0); PG8_BAR; PG8_MMA(0, 0, At, B0); PG8_MMA(0, 1, At, B1); PG8_BAR; PG8_SCHED;
            PG8_LDA(At, 0, 1); PG8_STAGE(PG8_SB(0, 0), b2, voffB); PG8_STAGE(PG8_SB(0, 1), b2 + hstep, voffB); PG8_STAGE(PG8_SA(0, 0), a2, voffA);
            PG8_WAIT_V(8); PG8_WAIT_L(0); PG8_BAR; PG8_MMA(1, 0, At, B0); PG8_MMA(1, 1, At, B1); PG8_BAR; PG8_SCHED;
            PG8_LDB(B0, 1, 0); PG8_LDB(B1, 1, 1); PG8_SCHED; PG8_LDA(At, 1, 0); PG8_STAGE(PG8_SA(0, 1), a2 + hstep, voffA);
            PG8_WAIT_V(8); PG8_WAIT_L(0); PG8_BAR; PG8_MMA(0, 0, At, B0); PG8_MMA(0, 1, At, B1); PG8_BAR; PG8_SCHED;
            PG8_LDA(At, 1, 1); PG8_STAGE(PG8_SB(1, 0), b3, voffB); PG8_STAGE(PG8_SB(1, 1), b3 + hstep, voffB); PG8_STAGE(PG8_SA(1, 0), a3, voffA);
            PG8_WAIT_V(8); PG8_WAIT_L(0); PG8_BAR; PG8_MMA(1, 0, At, B0); PG8_MMA(1, 1, At, B1); PG8_BAR; PG8_SCHED;
            } else {
            PG8_LDB(B0, 0, 0); PG8_SCHED; PG8_LDA(At, 0, 0); PG8_STAGE(PG8_SA(1, 1), a1 + hstep, voffA);
            PG8_WAIT_L(8); PG8_BAR; PG8_WAIT_L(0); PG8_MMA(0, 0, At, B0); PG8_BAR; PG8_SCHED;
            PG8_LDB(B1, 0, 1); PG8_STAGE(PG8_SB(0, 0), b2, voffB);
            PG8_BAR; PG8_WAIT_L(0); PG8_MMA(0, 1, At, B1); PG8_BAR;
            PG8_LDA(At, 0, 1); PG8_STAGE(PG8_SA(0, 0), a2, voffA);
            PG8_BAR; PG8_WAIT_L(0); PG8_MMA(1, 0, At, B0); PG8_BAR; PG8_SCHED;
            PG8_STAGE(PG8_SB(0, 1), b2 + hstep, voffB);
            PG8_WAIT_V(6); PG8_BAR; PG8_MMA(1, 1, At, B1); PG8_BAR;
            PG8_LDB(B0, 1, 0); PG8_SCHED; PG8_LDA(At, 1, 0); PG8_STAGE(PG8_SA(0, 1), a2 + hstep, voffA);
            PG8_WAIT_L(8); PG8_BAR; PG8_WAIT_L(0); PG8_MMA(0, 0, At, B0); PG8_BAR; PG8_SCHED;
            PG8_LDB(B1, 1, 1); PG8_STAGE(PG8_SB(1, 0), b3, voffB);
            PG8_BAR; PG8_WAIT_L(0); PG8_MMA(0, 1, At, B1); PG8_BAR;
            PG8_LDA(At, 1, 1); PG8_STAGE(PG8_SA(1, 0), a3, voffA);
            PG8_BAR; PG8_WAIT_L(0); PG8_MMA(1, 0, At, B0); PG8_BAR; PG8_SCHED;
            PG8_STAGE(PG8_SB(1, 1), b3 + hstep, voffB);
            PG8_WAIT_V(6); PG8_BAR; PG8_MMA(1, 1, At, B1); PG8_BAR;
            }
        }
        if constexpr (ALIGN_EPI) { if (wr == 0) PG8_BAR; }
        if constexpr (!Epi::AFTER_DRAIN) { E(acc, cur, wr, wc, fr, fq); S.done(cur); }
        if (!has_next) break;
#pragma unroll
        for (int a = 0; a < 2; ++a)
#pragma unroll
            for (int b = 0; b < 2; ++b)
#pragma unroll
                for (int m = 0; m < 4; ++m)
#pragma unroll
                    for (int n = 0; n < 2; ++n) acc[a][b][m][n] = (f32x4){0.f, 0.f, 0.f, 0.f};
        cur = nxt; cA = nA; cB = nB; ++ui;
        if constexpr (ALIGN_EPI) { if (wr == 1) PG8_BAR; }
    }
    PG8_WAIT_V(0);
    if constexpr (!ALIGN_EPI) { if (wr == 0) PG8_BAR; }
    PG8_BAR;
    if constexpr (Epi::AFTER_DRAIN) { E.fused(acc, cur, wr, wc, fr, fq, lds, wid, lane); S.done(cur); }
#undef PG8_SA
#undef PG8_SB
#undef PG8_STAGE
#undef PG8_LDA
#undef PG8_LDB
#undef PG8_MMA
#undef PG8_WAIT_V
#undef PG8_WAIT_L
#undef PG8_BAR
#undef PG8_SCHED
}
}

template <class F> struct PgEpi {
  static constexpr bool PERM = false, AFTER_DRAIN = false;
  F f;
  __device__ __forceinline__ void operator()(const pg8::f32x4 (&acc)[2][2][4][2], const pg8::Unit& u, int wr, int wc, int fr, int fq) const {
#pragma unroll
    for (int ai = 0; ai < 2; ++ai)
#pragma unroll
      for (int m = 0; m < 4; ++m) {
        int row = u.pm * 256 + ai * 128 + wr * 64 + m * 16 + fr; asm volatile("" : "+v"(row));
#pragma unroll
        for (int bj = 0; bj < 2; ++bj)
#pragma unroll
          for (int n = 0; n < 2; ++n) {
            const int col = u.pn * 256 + bj * 128 + wc * 32 + n * 16 + fq * 4;
            const pg8::f32x4 a = acc[ai][bj][m][n];
            f.elem(row, col, (f32x4){a[0], a[1], a[2], a[3]});
          }
        if (m & 1) asm volatile("" ::: "memory");
      }
  }
};
struct InElem {
  char* ws;
  DI void elem8(int row_, int col, f32x4 v, f32x4 w) const {
    if (col >= DIN) return;
    const size_t row = row_;
    bf16_t* d;
    if (col < 1920) d = (bf16_t*)(ws + OFF_ZRW) + row * 1920 + col;
    else if (col < 2304) d = (bf16_t*)(ws + OFF_ZQ) + row * 384 + (col - 1920);
    else if (col < 2560) d = (bf16_t*)(ws + OFF_ZKV) + row * 256 + (col - 2304);
    else if (col < 2592) d = (bf16_t*)(ws + OFF_ZKR) + row * 32 + (col - 2560);
    else {
      v = (f32x4){sigm(v[0]), sigm(v[1]), sigm(v[2]), sigm(v[3])}; w = (f32x4){sigm(w[0]), sigm(w[1]), sigm(w[2]), sigm(w[3])};
      d = (col < 3616) ? (bf16_t*)(ws + OFF_GA) + row * 1024 + (col - 2592) : (bf16_t*)(ws + OFF_GB) + row * 1024 + (col - 3616);
    }
    *(u32x4*)d = (u32x4){pk2(v[0], v[1]), pk2(v[2], v[3]), pk2(w[0], w[1]), pk2(w[2], w[3])};
  }
  DI void elem(int row_, int col, f32x4 v) const {
    if (col >= DIN) return;
    const size_t row = row_;
    bf16_t* d;
    if (col < 1920) d = (bf16_t*)(ws + OFF_ZRW) + row * 1920 + col;
    else if (col < 2304) d = (bf16_t*)(ws + OFF_ZQ) + row * 384 + (col - 1920);
    else if (col < 2560) d = (bf16_t*)(ws + OFF_ZKV) + row * 256 + (col - 2304);
    else if (col < 2592) d = (bf16_t*)(ws + OFF_ZKR) + row * 32 + (col - 2560);
    else {
      v = (f32x4){sigm(v[0]), sigm(v[1]), sigm(v[2]), sigm(v[3])};
      d = (col < 3616) ? (bf16_t*)(ws + OFF_GA) + row * 1024 + (col - 2592) : (bf16_t*)(ws + OFF_GB) + row * 1024 + (col - 3616);
    }
    *(u32x2*)d = (u32x2){pk2(v[0], v[1]), pk2(v[2], v[3])};
  }
};
struct Relu2Elem {
  bf16_t* out;
  DI void elem8(int row_, int col, f32x4 v, f32x4 w) const {
#pragma unroll
    for (int j = 0; j < 4; ++j) { const float r = fmaxf(v[j], 0.f); v[j] = r * r; const float q = fmaxf(w[j], 0.f); w[j] = q * q; }
    *(u32x4*)(out + (size_t)row_ * DFF + col) = (u32x4){pk2(v[0], v[1]), pk2(v[2], v[3]), pk2(w[0], w[1]), pk2(w[2], w[3])};
  }
  DI void elem(int row_, int col, f32x4 v) const {
#pragma unroll
    for (int j = 0; j < 4; ++j) { const float r = fmaxf(v[j], 0.f); v[j] = r * r; }
    *(u32x2*)(out + (size_t)row_ * DFF + col) = (u32x2){pk2(v[0], v[1]), pk2(v[2], v[3])};
  }
};
struct ResElem {
  const float* base; const float* gate; float* out;
  DI void elem(int row_, int col, f32x4 v) const {
    const size_t row = row_; const int b = row_ / SEQ;
    const f32x4 g = *(const f32x4*)(gate + b * 6144 + col) + 1.f;
    const f32x4 xb = *(const f32x4*)(base + row * DM + col);
    *(f32x4*)(out + row * DM + col) = xb * DN_ALPHA + g * v;
  }
};
template <class F> struct PgEpi8 {
  static constexpr bool PERM = true, AFTER_DRAIN = false;
  F f;
  __device__ __forceinline__ void operator()(const pg8::f32x4 (&acc)[2][2][4][2], const pg8::Unit& u, int wr, int wc, int fr, int fq) const {
#pragma unroll
    for (int ai = 0; ai < 2; ++ai)
#pragma unroll
      for (int m = 0; m < 4; ++m) {
        int row = u.pm * 256 + ai * 128 + wr * 64 + m * 16 + fr; asm volatile("" : "+v"(row));
#pragma unroll
        for (int bj = 0; bj < 2; ++bj) {
          const int col = u.pn * 256 + bj * 128 + wc * 32 + fq * 8;
          const pg8::f32x4 a = acc[ai][bj][m][0], b = acc[ai][bj][m][1];
          f.elem8(row, col, (f32x4){a[0], a[1], a[2], a[3]}, (f32x4){b[0], b[1], b[2], b[3]});
        }
        if (m & 1) asm volatile("" ::: "memory");
      }
  }
};
struct MixElem {
  const bf16_t* gate; bf16_t* mixed; int pass;
  DI void elem8(int row_, int col, f32x4 v, f32x4 w) const {
    const size_t o = (size_t)row_ * DM + col;
    const u32x4 g = *(const u32x4*)(gate + o);
    v *= (f32x4){bflo(g[0]), bfhi(g[0]), bflo(g[1]), bfhi(g[1])}; w *= (f32x4){bflo(g[2]), bfhi(g[2]), bflo(g[3]), bfhi(g[3])};
    if (pass) { const u32x4 mm = *(const u32x4*)(mixed + o);
      v += (f32x4){bflo(mm[0]), bfhi(mm[0]), bflo(mm[1]), bfhi(mm[1])}; w += (f32x4){bflo(mm[2]), bfhi(mm[2]), bflo(mm[3]), bfhi(mm[3])}; }
    *(u32x4*)(mixed + o) = (u32x4){pk2(v[0], v[1]), pk2(v[2], v[3]), pk2(w[0], w[1]), pk2(w[2], w[3])};
  }
};
struct T1bElem {
  const float* base; const float* gate; bf16_t* out;
  DI void elem8(int row_, int col, f32x4 v, f32x4 w) const {
    const size_t row = row_; const int b = row_ / SEQ;
    const f32x4 g0 = *(const f32x4*)(gate + b * 6144 + col) + 1.f, g1 = *(const f32x4*)(gate + b * 6144 + col + 4) + 1.f;
    const f32x4 x0 = *(const f32x4*)(base + row * DM + col), x1 = *(const f32x4*)(base + row * DM + col + 4);
    const f32x4 t0 = x0 * DN_ALPHA + g0 * v, t1 = x1 * DN_ALPHA + g1 * w;
    *(u32x4*)(out + row * DM + col) = (u32x4){pk2(t0[0], t0[1]), pk2(t0[2], t0[3]), pk2(t1[0], t1[1]), pk2(t1[2], t1[3])};
  }
};
struct Res2bElem {
  const bf16_t* t1; const float* stats; const float *g1, *b1; const float* gate; float* out;
  DI void elem8(int row_, int col, f32x4 v, f32x4 w) const {
    const size_t row = row_; const int b = row_ / SEQ;
    const f32x2 st = *(const f32x2*)(stats + row * 2);
    const u32x4 tt = *(const u32x4*)(t1 + row * DM + col);
    const f32x4 ta = (f32x4){bflo(tt[0]), bfhi(tt[0]), bflo(tt[1]), bfhi(tt[1])}, tb = (f32x4){bflo(tt[2]), bfhi(tt[2]), bflo(tt[3]), bfhi(tt[3])};
    const f32x4 xa = (ta - st[0]) * st[1] * *(const f32x4*)(g1 + col) + *(const f32x4*)(b1 + col);
    const f32x4 xb = (tb - st[0]) * st[1] * *(const f32x4*)(g1 + col + 4) + *(const f32x4*)(b1 + col + 4);
    const f32x4 ga = *(const f32x4*)(gate + b * 6144 + col) + 1.f, gb = *(const f32x4*)(gate + b * 6144 + col + 4) + 1.f;
    *(f32x4*)(out + row * DM + col) = xa * DN_ALPHA + ga * v;
    *(f32x4*)(out + row * DM + col + 4) = xb * DN_ALPHA + gb * w;
  }
};
template <class F>
DI void pg8_gemm8(char* smem, const bf16_t* A, const bf16_t* Bt, int M, int N, int K, const F& f) {
  pg8::StaticOrder S; S.init(M, N, (int)gridDim.x, (int)blockIdx.x);
  PgEpi8<F> E{f};
  pg8::gemm_phase<PgEpi8<F>, pg8::StaticOrder, true, true>((PG8_LAS unsigned char*)smem, pg8::Gemm{A, Bt, M, N, K}, S, E);
}
struct Res2Elem {
  const float* t1; const float* stats; const float *g1, *b1; const float* gate; float* out;
  DI void elem(int row_, int col, f32x4 v) const {
    const size_t row = row_; const int b = row_ / SEQ;
    const f32x2 st = *(const f32x2*)(stats + row * 2);
    const f32x4 x1 = (*(const f32x4*)(t1 + row * DM + col) - st[0]) * st[1] * *(const f32x4*)(g1 + col) + *(const f32x4*)(b1 + col);
    const f32x4 g = *(const f32x4*)(gate + b * 6144 + col) + 1.f;
    *(f32x4*)(out + row * DM + col) = x1 * DN_ALPHA + g * v;
  }
};
template <class F>
DI void pg8_gemm(char* smem, const bf16_t* A, const bf16_t* Bt, int M, int N, int K, const F& f) {
  pg8::StaticOrder S; S.init(M, N, (int)gridDim.x, (int)blockIdx.x);
  PgEpi<F> E{f};
  pg8::gemm_phase<PgEpi<F>, pg8::StaticOrder, true, true>((PG8_LAS unsigned char*)smem, pg8::Gemm{A, Bt, M, N, K}, S, E);
}

DI void conv8(float (&o)[8], const bf16_t* zrow, int col, bool hp, bool hn, const float* __restrict__ cw) {
  const u32x4 zc = *(const u32x4*)(zrow + col);
  u32x4 zp = (u32x4){0, 0, 0, 0}, zn = (u32x4){0, 0, 0, 0};
  if (hp) zp = *(const u32x4*)(zrow - 1920 + col);
  if (hn) zn = *(const u32x4*)(zrow + 1920 + col);
#pragma unroll
  for (int e = 0; e < 4; ++e) {
    const f32x2 w0 = *(const f32x2*)(cw + col + 2 * e), w1 = *(const f32x2*)(cw + 1920 + col + 2 * e), w2 = *(const f32x2*)(cw + 3840 + col + 2 * e);
    o[2 * e] = w0[0] * bflo(zp[e]) + w1[0] * bflo(zc[e]) + w2[0] * bflo(zn[e]);
    o[2 * e + 1] = w0[1] * bfhi(zp[e]) + w1[1] * bfhi(zc[e]) + w2[1] * bfhi(zn[e]);
  }
}
DI void load_cw(float (&w)[24], const float* __restrict__ cw, int col) {
#pragma unroll
  for (int j = 0; j < 3; ++j)
#pragma unroll
    for (int e = 0; e < 4; ++e) { const f32x2 t = *(const f32x2*)(cw + j * 1920 + col + 2 * e); w[j * 8 + 2 * e] = t[0]; w[j * 8 + 2 * e + 1] = t[1]; }
}
DI void conv8w(float (&o)[8], const bf16_t* zrow, int col, bool hp, bool hn, const float (&w)[24]) {
  const u32x4 zc = *(const u32x4*)(zrow + col);
  u32x4 zp = (u32x4){0, 0, 0, 0}, zn = (u32x4){0, 0, 0, 0};
  if (hp) zp = *(const u32x4*)(zrow - 1920 + col);
  if (hn) zn = *(const u32x4*)(zrow + 1920 + col);
#pragma unroll
  for (int e = 0; e < 4; ++e) {
    o[2 * e] = w[2 * e] * bflo(zp[e]) + w[8 + 2 * e] * bflo(zc[e]) + w[16 + 2 * e] * bflo(zn[e]);
    o[2 * e + 1] = w[2 * e + 1] * bfhi(zp[e]) + w[8 + 2 * e + 1] * bfhi(zc[e]) + w[16 + 2 * e + 1] * bfhi(zn[e]);
  }
}
DI u32x4 pack8(const float (&o)[8]) { return (u32x4){pk2(o[0], o[1]), pk2(o[2], o[3]), pk2(o[4], o[5]), pk2(o[6], o[7])}; }

struct ZL3 { u32x4 c, p, n; };
DI void load_z3(ZL3& z, const bf16_t* zrow, int col, bool hp, bool hn) {
  z.c = *(const u32x4*)(zrow + col);
  z.p = (u32x4){0, 0, 0, 0}; z.n = (u32x4){0, 0, 0, 0};
  if (hp) z.p = *(const u32x4*)(zrow - 1920 + col);
  if (hn) z.n = *(const u32x4*)(zrow + 1920 + col);
}
DI void conv_z3(float (&o)[8], const ZL3& z, const float (&w)[24]) {
#pragma unroll
  for (int e = 0; e < 4; ++e) {
    o[2 * e] = w[2 * e] * bflo(z.p[e]) + w[8 + 2 * e] * bflo(z.c[e]) + w[16 + 2 * e] * bflo(z.n[e]);
    o[2 * e + 1] = w[2 * e + 1] * bfhi(z.p[e]) + w[8 + 2 * e + 1] * bfhi(z.c[e]) + w[16 + 2 * e + 1] * bfhi(z.n[e]);
  }
}
DI void phase2(const Params& p) {
  char* ws = launder(p.ws);
  const bf16_t* zrw = (const bf16_t*)(ws + OFF_ZRW);
  bf16_t *R = (bf16_t*)(ws + OFF_R), *K = (bf16_t*)(ws + OFF_K), *V = (bf16_t*)(ws + OFF_V), *TW = (bf16_t*)(ws + OFF_TW), *ZA = (bf16_t*)(ws + OFF_ZA), *SG = (bf16_t*)(ws + OFF_SG);
  float *kinv = (float*)(ws + OFF_KINV), *rkdot = (float*)(ws + OFF_RKDOT), *rsq = (float*)(ws + OFF_RSQ), *rskv = (float*)(ws + OFF_RSKV), *cs = (float*)(ws + OFF_CS);
  const bf16_t *zq = (const bf16_t*)(ws + OFF_ZQ), *zkv = (const bf16_t*)(ws + OFF_ZKV), *zkr = (const bf16_t*)(ws + OFF_ZKR);
  bf16_t* kpe = (bf16_t*)(ws + OFF_KPE);
  const int lane = tidx() & 63, wid = tidx() >> 6;
  const float invf = powf(10000.f, -(float)(lane & 15) * (1.f / 16.f));
  float cwr[24], cwk[24], cwv[24], kkw[8], rkw[8];
  load_cw(cwr, p.rw_conv, 8 * lane); load_cw(cwk, p.rw_conv, 512 + 8 * lane); load_cw(cwv, p.rw_conv, 1024 + 8 * lane);
  float cwx[24];
  load_cw(cwx, p.rw_conv, 1536 + 8 * (lane < 48 ? lane : 0));
#pragma unroll
  for (int e = 0; e < 8; ++e) { kkw[e] = p.rw_k_k[8 * lane + e]; rkw[e] = p.rw_r_k[8 * lane + e]; }
  const int l47 = lane < 48 ? lane : 47, l31 = lane & 31, l15 = lane & 15;
  for (int tok = blockIdx.x * 8 + wid; tok < NTOK; tok += gridDim.x * 8) {
    const int s = tok % SEQ; const bool hp = s > 0, hn = s < SEQ - 1;
    const bf16_t* zrow = zrw + (size_t)tok * 1920;
    ZL3 zr, zk, zv, zx;
    load_z3(zr, zrow, 8 * lane, hp, hn); load_z3(zk, zrow, 512 + 8 * lane, hp, hn); load_z3(zv, zrow, 1024 + 8 * lane, hp, hn);
    load_z3(zx, zrow, 1536 + 8 * l47, hp, hn);
    const u32x4 zqv = *(const u32x4*)(zq + (size_t)tok * 384 + 8 * l47);
    const u32x4 zkvv = *(const u32x4*)(zkv + (size_t)tok * 256 + 8 * l31);
    const unsigned short kr1 = zkr[(size_t)tok * 32 + l15], kr2 = zkr[(size_t)tok * 32 + 16 + l15];
    const int posv = p.pos[tok];
    float r8[8], k8[8], v8[8];
    conv_z3(r8, zr, cwr); conv_z3(k8, zk, cwk); conv_z3(v8, zv, cwv);
    *(u32x4*)(R + (size_t)tok * 512 + 8 * lane) = pack8(r8);
    *(u32x4*)(K + (size_t)tok * 512 + 8 * lane) = pack8(k8);
    *(u32x4*)(V + (size_t)tok * 512 + 8 * lane) = pack8(v8);
    float ss = 0.f, rk = 0.f;
#pragma unroll
    for (int e = 0; e < 8; ++e) { const float kk = k8[e] * kkw[e]; ss += kk * kk; rk += r8[e] * k8[e] * rkw[e]; }
    ss += __shfl_xor(ss, 1); ss += __shfl_xor(ss, 2); ss += __shfl_xor(ss, 4);
    rk += __shfl_xor(rk, 1); rk += __shfl_xor(rk, 2); rk += __shfl_xor(rk, 4);
    if ((lane & 7) == 0) { kinv[(size_t)tok * 8 + (lane >> 3)] = 1.f / fmaxf(sqrtf(ss), 1e-12f); rkdot[(size_t)tok * 8 + (lane >> 3)] = rk; }
    if (lane < 48) {
      float o[8];
      conv_z3(o, zx, cwx);
      if (lane < 16) {
#pragma unroll
        for (int e = 0; e < 8; ++e) o[e] = 1.f - 2.f / (1.f + __expf(2.f * o[e]));
        *(u32x4*)(TW + (size_t)tok * 128 + 8 * lane) = pack8(o);
      } else if (lane < 32) {
        *(u32x4*)(ZA + (size_t)tok * 128 + 8 * (lane - 16)) = pack8(o);
      } else {
#pragma unroll
        for (int e = 0; e < 8; ++e) o[e] = sigm(o[e]);
        *(u32x4*)(SG + (size_t)tok * 128 + 8 * (lane - 32)) = pack8(o);
      }
    }
    float sq = 0.f, skv = 0.f;
    if (lane < 48) {
#pragma unroll
      for (int e = 0; e < 4; ++e) { const float a = bflo(zqv[e]), b2 = bfhi(zqv[e]); sq += a * a + b2 * b2; } }
    if (lane < 32) {
#pragma unroll
      for (int e = 0; e < 4; ++e) { const float a = bflo(zkvv[e]), b2 = bfhi(zkvv[e]); skv += a * a + b2 * b2; } }
#pragma unroll
    for (int m = 1; m < 64; m <<= 1) { sq += __shfl_xor(sq, m); skv += __shfl_xor(skv, m); }
    if (lane == 0) { rsq[tok] = rsqrtf(sq * (1.f / 384.f) + 1e-6f); rskv[tok] = rsqrtf(skv * (1.f / 256.f) + 1e-6f); }
    if (lane < 16) {
      const float ang = (float)posv * invf;
      float si, co; sincosf(ang, &si, &co);
      cs[(size_t)tok * 32 + lane] = co; cs[(size_t)tok * 32 + 16 + lane] = si;
      const float x1 = bf2f(kr1), x2 = bf2f(kr2);
      kpe[(size_t)tok * 32 + lane] = f2bf(x1 * co - x2 * si);
      kpe[(size_t)tok * 32 + 16 + lane] = f2bf(x1 * si + x2 * co);
    }
  }
}

DI void scan_item(const Params& p, int pair, char* smem0) {
  char* ws = launder(p.ws);
  const int tid = tidx(), lane = tid & 63, w = (tid >> 6) & 3, half = __builtin_amdgcn_readfirstlane(tid >> 8);
  const int item = pair * 2 + half;
  const int dir = item & 1, h = (item >> 1) & 7, b = item >> 4;
  char* smem = smem0 + half * 53248;
  float* opbuf = (float*)smem;
  float* ybuf = (float*)(smem + 49152) + w * 256;
  const bf16_t *R = (const bf16_t*)(ws + OFF_R), *K = (const bf16_t*)(ws + OFF_K), *V = (const bf16_t*)(ws + OFF_V), *TW = (const bf16_t*)(ws + OFF_TW), *ZA = (const bf16_t*)(ws + OFF_ZA);
  const float* kinv = (const float*)(ws + OFF_KINV);
  bf16_t* Y = (bf16_t*)(ws + (dir ? OFF_YB : OFF_YF));
  const int n = w * 16 + (lane & 15), gc = h * 64 + n;
  bf16x8 bw[2], ba[2];
#pragma unroll
  for (int ks = 0; ks < 2; ++ks) {
    bw[ks] = *(const bf16x8*)((const bf16_t*)(ws + OFF_WW2) + ((size_t)(dir * 512 + gc)) * 64 + ks * 32 + (lane >> 4) * 8);
    ba[ks] = *(const bf16x8*)((const bf16_t*)(ws + OFF_WA2) + ((size_t)(dir * 512 + gc)) * 64 + ks * 32 + (lane >> 4) * 8);
  }
  const float w0v = p.rw_w0[dir * 512 + gc], a0v = p.rw_a0[dir * 512 + gc], kkv = p.rw_k_k[gc], kav = p.rw_k_a[gc];
  const int tokb = b * SEQ;
  auto tok_of = [&](int ci, int tau) -> int { const int t = ci * 16 + tau; return tokb + (dir ? (SEQ - 1 - t) : t); };
  bf16x8 ta[2], za[2]; unsigned short kr[4], rr[4], vr[4]; float kiv[4];
  auto prep_load = [&](int ci) {
    const int tk = tok_of(ci, lane & 15);
#pragma unroll
    for (int ks = 0; ks < 2; ++ks) {
      ta[ks] = *(const bf16x8*)(TW + (size_t)tk * 128 + dir * 64 + ks * 32 + (lane >> 4) * 8);
      za[ks] = *(const bf16x8*)(ZA + (size_t)tk * 128 + dir * 64 + ks * 32 + (lane >> 4) * 8);
    }
#pragma unroll
    for (int j = 0; j < 4; ++j) {
      const int t2 = tok_of(ci, (lane >> 4) * 4 + j);
      kr[j] = K[(size_t)t2 * 512 + gc]; rr[j] = R[(size_t)t2 * 512 + gc]; vr[j] = V[(size_t)t2 * 512 + gc]; kiv[j] = kinv[(size_t)t2 * 8 + h];
    }
  };
  auto prep_finish = [&](int stage) {
    f32x4 aw = (f32x4){0.f, 0.f, 0.f, 0.f}, aa = aw;
    aw = __builtin_amdgcn_mfma_f32_16x16x32_bf16(ta[0], bw[0], aw, 0, 0, 0); aw = __builtin_amdgcn_mfma_f32_16x16x32_bf16(ta[1], bw[1], aw, 0, 0, 0);
    aa = __builtin_amdgcn_mfma_f32_16x16x32_bf16(za[0], ba[0], aa, 0, 0, 0); aa = __builtin_amdgcn_mfma_f32_16x16x32_bf16(za[1], ba[1], aa, 0, 0, 0);
#pragma unroll
    for (int j = 0; j < 4; ++j) {
      const int tau = (lane >> 4) * 4 + j;
      const float kval = bf2f(kr[j]), rval = bf2f(rr[j]), vval = bf2f(vr[j]);
      const float u = w0v + aw[j];
      const float z = -u, sp = fmaxf(z, 0.f) + __logf(1.f + __expf(-fabsf(z)));
      const float dec = __expf(-__expf(-sp - 0.5f));
      const float alr = 1.f / (1.f + __expf(-(a0v + aa[j])));
      const float kkn = kval * kkv * kiv[j];
      float* ob = opbuf + stage * 6144 + tau * 384 + n;
      ob[0] = -kkn; ob[64] = dec; ob[128] = kkn * alr; ob[192] = kval * (1.f + (alr - 1.f) * kav); ob[256] = rval; ob[320] = vval;
    }
  };
  float S0[8], S1[8];
#pragma unroll
  for (int c = 0; c < 8; ++c) { S0[c] = 0.f; S1[c] = 0.f; }
  const int cq = lane & 7, rp = lane >> 3, irow = w * 16 + 2 * rp;
  struct Ops { f32x4 a0, a1, w0, w1, b0, b1, k0, k1, r0, r1; f32x2 v; };
  auto load_ops = [&](Ops& o, const float* obase, int tau) {
    const float* ob = obase + tau * 384 + cq * 8;
    o.a0 = *(const f32x4*)(ob); o.a1 = *(const f32x4*)(ob + 4);
    o.v = *(const f32x2*)(obase + tau * 384 + 320 + irow);
    o.w0 = *(const f32x4*)(ob + 64); o.w1 = *(const f32x4*)(ob + 68);
    o.b0 = *(const f32x4*)(ob + 128); o.b1 = *(const f32x4*)(ob + 132);
    o.k0 = *(const f32x4*)(ob + 192); o.k1 = *(const f32x4*)(ob + 196);
    o.r0 = *(const f32x4*)(ob + 256); o.r1 = *(const f32x4*)(ob + 260);
  };
  auto red8 = [&](float x) -> float { x += dppf<0xB1>(x); x += dppf<0x4E>(x); x += dppf<0x141>(x); return x; };
  auto step = [&](const Ops& o, int tau) {
    float A[8], W[8], Bv[8], Kv[8], Rv[8];
#pragma unroll
    for (int e = 0; e < 4; ++e) { A[e] = o.a0[e]; A[4 + e] = o.a1[e]; W[e] = o.w0[e]; W[4 + e] = o.w1[e]; Bv[e] = o.b0[e]; Bv[4 + e] = o.b1[e];
      Kv[e] = o.k0[e]; Kv[4 + e] = o.k1[e]; Rv[e] = o.r0[e]; Rv[4 + e] = o.r1[e]; }
    float sa0 = mul_s(S0[0], A[0]), sa1 = mul_s(S1[0], A[0]);
#pragma unroll
    for (int c = 1; c < 8; ++c) { sa0 = fma_s(S0[c], A[c], sa0); sa1 = fma_s(S1[c], A[c], sa1); }
    float t0[8], t1[8];
#pragma unroll
    for (int c = 0; c < 8; ++c) { t0[c] = mul_s(o.v[0], Kv[c]); t1[c] = mul_s(o.v[1], Kv[c]); }
    sa0 = red8(sa0); sa1 = red8(sa1);
    float y0 = 0.f, y1 = 0.f;
#pragma unroll
    for (int c = 0; c < 8; ++c) {
      S0[c] = fma_s(S0[c], W[c], fma_s(sa0, Bv[c], t0[c]));
      S1[c] = fma_s(S1[c], W[c], fma_s(sa1, Bv[c], t1[c]));
      y0 = fma_s(S0[c], Rv[c], y0); y1 = fma_s(S1[c], Rv[c], y1);
    }
    y0 = red8(y0); y1 = red8(y1);
    if (cq == 0) *(f32x2*)(ybuf + tau * 16 + 2 * rp) = (f32x2){y0, y1};
  };
  prep_load(0); prep_finish(0); prep_load(1);
  __syncthreads();
  for (int ci = 0; ci < SEQ / 16; ++ci) {
    const bool more = ci + 1 < SEQ / 16;
    if (half == 1 && more) { prep_finish((ci + 1) & 1); if (ci + 2 < SEQ / 16) prep_load(ci + 2); }
    const float* obase = opbuf + (ci & 1) * 6144;
    Ops oa, ob2;
    load_ops(oa, obase, 0);
    for (int tau = 0; tau < 16; tau += 2) {
      load_ops(ob2, obase, tau + 1);
      __builtin_amdgcn_sched_barrier(0);
      step(oa, tau);
      __builtin_amdgcn_sched_barrier(0);
      if (tau + 2 < 16) load_ops(oa, obase, tau + 2);
      __builtin_amdgcn_sched_barrier(0);
      step(ob2, tau + 1);
      __builtin_amdgcn_sched_barrier(0);
    }
    {
      const int tau = lane >> 2, r4 = (lane & 3) * 4;
      const f32x4 yv = *(const f32x4*)(ybuf + tau * 16 + r4);
      *(u32x2*)(Y + (size_t)tok_of(ci, tau) * 512 + h * 64 + w * 16 + r4) = (u32x2){pk2(yv[0], yv[1]), pk2(yv[2], yv[3])};
    }
    if (half == 0 && more) { prep_finish((ci + 1) & 1); if (ci + 2 < SEQ / 16) prep_load(ci + 2); }
    __syncthreads();
  }
}

constexpr int KROW = 208, VROW = 136, KT_BYTES = 64 * KROW, VT_BYTES = 64 * VROW, ATT_STAGE = KT_BYTES + VT_BYTES;
DI int crow16(int i, int hh) { return (i & 3) + 8 * (i >> 2) + 4 * hh; }
DI void attn_item(const Params& p, int item, char* smem) {
  char* ws = launder(p.ws);
  const int qb = item & 7, bh = item >> 3, b = bh >> 3, h = bh & 7;
  const int tid = tidx(), lane = tid & 63, w = tid >> 6, l31 = lane & 31, hh = lane >> 5;
  const bf16_t* Q = (const bf16_t*)(ws + OFF_Q) + ((size_t)bh * SEQ + qb * 256 + w * 32 + l31) * 96;
  const bf16_t* Kn = (const bf16_t*)(ws + OFF_KN) + (size_t)bh * SEQ * 64;
  const bf16_t* Kpe = (const bf16_t*)(ws + OFF_KPE) + (size_t)b * SEQ * 32;
  const bf16_t* VT = (const bf16_t*)(ws + OFF_VT) + (size_t)bh * 64 * SEQ;
  bf16x8 qf[6];
#pragma unroll
  for (int ks = 0; ks < 6; ++ks) qf[ks] = *(const bf16x8*)(Q + ks * 16 + hh * 8);
  u32x4 kreg[2], vreg[1];
  auto gload = [&](int kt) {
    const int k0 = kt * 64;
#pragma unroll
    for (int i = 0; i < 2; ++i) { const int cid = tid + 512 * i, key = cid / 12, c = cid % 12;
      if (cid < 768) kreg[i] = (c < 8) ? *(const u32x4*)(Kn + (size_t)(k0 + key) * 64 + c * 8) : *(const u32x4*)(Kpe + (size_t)(k0 + key) * 32 + (c - 8) * 8); }
#pragma unroll
    for (int i = 0; i < 1; ++i) { const int cid = tid, dv = cid >> 3, c = cid & 7; vreg[i] = *(const u32x4*)(VT + (size_t)dv * SEQ + k0 + c * 8); }
  };
  auto lstore = [&](int stage) {
    char* st = smem + stage * ATT_STAGE;
#pragma unroll
    for (int i = 0; i < 2; ++i) { const int cid = tid + 512 * i, key = cid / 12, c = cid % 12; if (cid < 768) *(u32x4*)(st + key * KROW + c * 16) = kreg[i]; }
#pragma unroll
    for (int i = 0; i < 1; ++i) { const int cid = tid, dv = cid >> 3, c = cid & 7; char* d = st + KT_BYTES + dv * VROW + c * 16;
      *(u32x2*)d = (u32x2){vreg[i][0], vreg[i][1]}; *(u32x2*)(d + 8) = (u32x2){vreg[i][2], vreg[i][3]}; }
  };
  f32x16 o0, o1;
#pragma unroll
  for (int i = 0; i < 16; ++i) { o0[i] = 0.f; o1[i] = 0.f; }
  float mrun = 0.f, lsum = 0.f;
  f32x16 negm;
#pragma unroll
  for (int i = 0; i < 16; ++i) negm[i] = 0.f;
  gload(0); lstore(0);
  __syncthreads();
  for (int kt = 0; kt < SEQ / 64; ++kt) {
    const bool more = kt + 1 < SEQ / 64;
    if (more) gload(kt + 1);
    __builtin_amdgcn_sched_barrier(0);
    const char* st = smem + (kt & 1) * ATT_STAGE;
    f32x16 s0 = negm, s1 = negm;
#pragma unroll
    for (int ks = 0; ks < 6; ++ks) {
      const bf16x8 k0f = *(const bf16x8*)(st + l31 * KROW + ks * 32 + hh * 16);
      const bf16x8 k1f = *(const bf16x8*)(st + (32 + l31) * KROW + ks * 32 + hh * 16);
      s0 = __builtin_amdgcn_mfma_f32_32x32x16_bf16(k0f, qf[ks], s0, 0, 0, 0);
      s1 = __builtin_amdgcn_mfma_f32_32x32x16_bf16(k1f, qf[ks], s1, 0, 0, 0);
    }
    float mx = fmaxf(s0[0], s1[0]);
#pragma unroll
    for (int i = 1; i < 16; ++i) mx = fmaxf(mx, fmaxf(s0[i], s1[i]));
    mx = fmaxf(mx, __shfl_xor(mx, 32));
    if (kt == 0 || __any(mx > 8.f)) {
      const float alpha = __builtin_amdgcn_exp2f(-mx);
      mrun += mx; lsum *= alpha;
#pragma unroll
      for (int i = 0; i < 16; ++i) { s0[i] -= mx; s1[i] -= mx; o0[i] *= alpha; o1[i] *= alpha; negm[i] = -mrun; }
    }
    float ps = 0.f;
#pragma unroll
    for (int i = 0; i < 16; ++i) { s0[i] = __builtin_amdgcn_exp2f(s0[i]); s1[i] = __builtin_amdgcn_exp2f(s1[i]); ps += s0[i] + s1[i]; }
    lsum += ps;
    const char* vt = st + KT_BYTES;
#pragma unroll
    for (int s4 = 0; s4 < 4; ++s4) {
      const int ss = s4 & 1;
      u32x4 pw;
      if (s4 < 2) pw = (u32x4){pk2(s0[8 * ss], s0[8 * ss + 1]), pk2(s0[8 * ss + 2], s0[8 * ss + 3]), pk2(s0[8 * ss + 4], s0[8 * ss + 5]), pk2(s0[8 * ss + 6], s0[8 * ss + 7])};
      else pw = (u32x4){pk2(s1[8 * ss], s1[8 * ss + 1]), pk2(s1[8 * ss + 2], s1[8 * ss + 3]), pk2(s1[8 * ss + 4], s1[8 * ss + 5]), pk2(s1[8 * ss + 6], s1[8 * ss + 7])};
      const bf16x8 pf = __builtin_bit_cast(bf16x8, pw);
      const int koff = (s4 * 16 + 4 * hh) * 2;
      const u32x2 a0 = *(const u32x2*)(vt + l31 * VROW + koff), a1 = *(const u32x2*)(vt + l31 * VROW + koff + 16);
      const u32x2 b0 = *(const u32x2*)(vt + (32 + l31) * VROW + koff), b1 = *(const u32x2*)(vt + (32 + l31) * VROW + koff + 16);
      const bf16x8 v0f = __builtin_bit_cast(bf16x8, ((u32x4){a0[0], a0[1], a1[0], a1[1]}));
      const bf16x8 v1f = __builtin_bit_cast(bf16x8, ((u32x4){b0[0], b0[1], b1[0], b1[1]}));
      o0 = __builtin_amdgcn_mfma_f32_32x32x16_bf16(v0f, pf, o0, 0, 0, 0);
      o1 = __builtin_amdgcn_mfma_f32_32x32x16_bf16(v1f, pf, o1, 0, 0, 0);
    }
    __builtin_amdgcn_sched_barrier(0);
    if (more) lstore((kt + 1) & 1);
    __syncthreads();
  }
  lsum += __shfl_xor(lsum, 32);
  const float inv = 1.f / lsum;
  bf16_t* O = (bf16_t*)(ws + OFF_YMLA) + ((size_t)b * SEQ + qb * 256 + w * 32 + l31) * 512 + h * 64;
#pragma unroll
  for (int g = 0; g < 4; ++g) {
    const int dv = 8 * g + 4 * hh;
    *(u32x2*)(O + dv) = (u32x2){pk2(o0[4 * g] * inv, o0[4 * g + 1] * inv), pk2(o0[4 * g + 2] * inv, o0[4 * g + 3] * inv)};
    *(u32x2*)(O + 32 + dv) = (u32x2){pk2(o1[4 * g] * inv, o1[4 * g + 1] * inv), pk2(o1[4 * g + 2] * inv, o1[4 * g + 3] * inv)};
  }
}

DI void phase5(const Params& p, char* smem) {
  char* ws = launder(p.ws);
  bf16_t* mixed = (bf16_t*)(ws + OFF_MIXED);
  const int lane = tidx() & 63, wid = tidx() >> 6;
  const int nT = (NTOK / 256) * 4;
  for (int t2 = 2 * blockIdx.x; t2 < 2 * nT; t2 += 2 * gridDim.x) {
    for (int pass = 0; pass < 2; ++pass) {
      const int t = t2 >> 1;
      const int m0 = (t >> 2) * 256, n0 = (t & 3) * 256;
      const int rb = m0 + (wid >> 2) * 128, cb = n0 + (wid & 3) * 64;
      const bf16_t* Aop = (const bf16_t*)(ws + (pass ? OFF_YMLA : OFF_YRW));
      const bf16_t* Wop = (const bf16_t*)(ws + (pass ? OFF_WBR2 : OFF_WBR1));
      const bf16_t* gate = (const bf16_t*)(ws + (pass ? OFF_GB : OFF_GA));
      f32x4 acc[MI][4];
      zero_acc(acc);
      gemm_tile_acc(acc, Aop, 512, Wop, 512, m0, n0, 512, smem);
#pragma unroll
      for (int mi = 0; mi < MI; ++mi) {
        int row_ = rb + mi * 16 + (lane & 15); asm volatile("" : "+v"(row_) :: "memory");
#pragma unroll
        for (int ni = 0; ni < 4; ++ni) {
          const size_t o = (size_t)row_ * DM + cb + ni * 16 + (lane >> 4) * 4;
          const u32x2 g = *(const u32x2*)(gate + o);
          f32x4 v = acc[mi][ni] * (f32x4){bflo(g[0]), bfhi(g[0]), bflo(g[1]), bfhi(g[1])};
          if (pass) { const u32x2 mm = *(const u32x2*)(mixed + o); v += (f32x4){bflo(mm[0]), bfhi(mm[0]), bflo(mm[1]), bfhi(mm[1])}; }
          *(u32x2*)(mixed + o) = (u32x2){pk2(v[0], v[1]), pk2(v[2], v[3])};
        }
      }
    }
  }
}

template <bool WITH_H>
DI void ln_phase(const float* in, float* outp, const float* __restrict__ g, const float* __restrict__ be, const float* mod, bf16_t* hout) {
  const int lane = tidx() & 63, wid = tidx() >> 6;
  constexpr int R = 4;
  for (int rb = (blockIdx.x * 8 + wid) * R; rb < NTOK; rb += gridDim.x * 8 * R) {
    f32x4 v[R][4]; float s[R], q[R];
#pragma unroll
    for (int r = 0; r < R; ++r)
#pragma unroll
      for (int i = 0; i < 4; ++i) v[r][i] = *(const f32x4*)(in + (size_t)(rb + r) * DM + i * 256 + lane * 4);
#pragma unroll
    for (int r = 0; r < R; ++r) { s[r] = 0.f;
#pragma unroll
      for (int i = 0; i < 4; ++i) s[r] += (v[r][i][0] + v[r][i][1]) + (v[r][i][2] + v[r][i][3]); }
#pragma unroll
    for (int m = 1; m < 64; m <<= 1)
#pragma unroll
      for (int r = 0; r < R; ++r) s[r] += __shfl_xor(s[r], m);
#pragma unroll
    for (int r = 0; r < R; ++r) { const float mean = s[r] * (1.f / 1024.f); s[r] = mean; q[r] = 0.f;
#pragma unroll
      for (int i = 0; i < 4; ++i) { const f32x4 d = v[r][i] - mean; q[r] += (d[0] * d[0] + d[1] * d[1]) + (d[2] * d[2] + d[3] * d[3]); } }
#pragma unroll
    for (int m = 1; m < 64; m <<= 1)
#pragma unroll
      for (int r = 0; r < R; ++r) q[r] += __shfl_xor(q[r], m);
    const int b = rb / SEQ;
#pragma unroll
    for (int r = 0; r < R; ++r) {
      const int row = rb + r;
      const float mean = s[r], rstd = rsqrtf(q[r] * (1.f / 1024.f) + 1e-5f);
      if (WITH_H && lane == 0) *(f32x2*)(outp + (size_t)row * 2) = (f32x2){mean, rstd};
#pragma unroll
      for (int i = 0; i < 4; ++i) {
        const int col = i * 256 + lane * 4;
        const f32x4 o = (v[r][i] - mean) * rstd * *(const f32x4*)(g + col) + *(const f32x4*)(be + col);
        if (!WITH_H) *(f32x4*)(outp + (size_t)row * DM + col) = o;
        if (WITH_H) {
          const f32x4 sh = *(const f32x4*)(mod + b * 6144 + 3072 + col), sc = *(const f32x4*)(mod + b * 6144 + 4096 + col) + 1.f;
          const f32x4 hv = o * sc + sh;
          *(u32x2*)(hout + (size_t)row * DM + col) = (u32x2){pk2(hv[0], hv[1]), pk2(hv[2], hv[3])};
        }
      }
    }
  }
}

DI void ln1_phase(const bf16_t* in, float* stats, const float* __restrict__ g, const float* __restrict__ be, const float* mod, bf16_t* hout) {
  const int lane = tidx() & 63, wid = tidx() >> 6;
  constexpr int R = 4;
  for (int rb = (blockIdx.x * 8 + wid) * R; rb < NTOK; rb += gridDim.x * 8 * R) {
    u32x4 raw[R][2]; f32x4 v[R][4]; float s[R], q[R];
#pragma unroll
    for (int r = 0; r < R; ++r)
#pragma unroll
      for (int i = 0; i < 2; ++i) raw[r][i] = *(const u32x4*)(in + (size_t)(rb + r) * DM + i * 512 + lane * 8);
#pragma unroll
    for (int r = 0; r < R; ++r) { s[r] = 0.f;
#pragma unroll
      for (int i = 0; i < 2; ++i) {
        v[r][2 * i] = (f32x4){bflo(raw[r][i][0]), bfhi(raw[r][i][0]), bflo(raw[r][i][1]), bfhi(raw[r][i][1])};
        v[r][2 * i + 1] = (f32x4){bflo(raw[r][i][2]), bfhi(raw[r][i][2]), bflo(raw[r][i][3]), bfhi(raw[r][i][3])};
        s[r] += ((v[r][2 * i][0] + v[r][2 * i][1]) + (v[r][2 * i][2] + v[r][2 * i][3])) + ((v[r][2 * i + 1][0] + v[r][2 * i + 1][1]) + (v[r][2 * i + 1][2] + v[r][2 * i + 1][3]));
      } }
#pragma unroll
    for (int m = 1; m < 64; m <<= 1)
#pragma unroll
      for (int r = 0; r < R; ++r) s[r] += __shfl_xor(s[r], m);
#pragma unroll
    for (int r = 0; r < R; ++r) { const float mean = s[r] * (1.f / 1024.f); s[r] = mean; q[r] = 0.f;
#pragma unroll
      for (int i = 0; i < 4; ++i) { const f32x4 d = v[r][i] - mean; q[r] += (d[0] * d[0] + d[1] * d[1]) + (d[2] * d[2] + d[3] * d[3]); } }
#pragma unroll
    for (int m = 1; m < 64; m <<= 1)
#pragma unroll
      for (int r = 0; r < R; ++r) q[r] += __shfl_xor(q[r], m);
    const int b = rb / SEQ;
#pragma unroll
    for (int r = 0; r < R; ++r) {
      const int row = rb + r;
      const float mean = s[r], rstd = rsqrtf(q[r] * (1.f / 1024.f) + 1e-5f);
      if (lane == 0) *(f32x2*)(stats + (size_t)row * 2) = (f32x2){mean, rstd};
#pragma unroll
      for (int i = 0; i < 2; ++i) {
        const int col = i * 512 + lane * 8;
        f32x4 hv[2];
#pragma unroll
        for (int hh = 0; hh < 2; ++hh) {
          const int c = col + 4 * hh;
          const f32x4 o = (v[r][2 * i + hh] - mean) * rstd * *(const f32x4*)(g + c) + *(const f32x4*)(be + c);
          const f32x4 sh = *(const f32x4*)(mod + b * 6144 + 3072 + c), sc = *(const f32x4*)(mod + b * 6144 + 4096 + c) + 1.f;
          hv[hh] = o * sc + sh;
        }
        *(u32x4*)(hout + (size_t)row * DM + col) = (u32x4){pk2(hv[0][0], hv[0][1]), pk2(hv[0][2], hv[0][3]), pk2(hv[1][0], hv[1][1]), pk2(hv[1][2], hv[1][3])};
      }
    }
  }
}

DI void gsync(unsigned* bar, unsigned& target) {
  asm volatile("s_waitcnt vmcnt(0) lgkmcnt(0)" ::: "memory");
  __syncthreads();
  target += gridDim.x;
  if (tidx() == 0) {
    __builtin_amdgcn_fence(__ATOMIC_RELEASE, "agent");
    asm volatile("s_waitcnt vmcnt(0)" ::: "memory");
    __hip_atomic_fetch_add(bar, 1u, __ATOMIC_RELAXED, __HIP_MEMORY_SCOPE_AGENT);
    while (__hip_atomic_load(bar, __ATOMIC_RELAXED, __HIP_MEMORY_SCOPE_AGENT) < target) __builtin_amdgcn_s_sleep(4);
    __builtin_amdgcn_fence(__ATOMIC_ACQUIRE, "agent");
    asm volatile("s_waitcnt vmcnt(0)" ::: "memory");
  }
  __syncthreads();
}

__global__ void __launch_bounds__(512, 2) fwd_mega(Params p) {
  __shared__ __attribute__((aligned(16))) char smem[131072];
  cg::grid_group grid = cg::this_grid();
  char* ws = launder(p.ws);
  unsigned* bar = (unsigned*)p.ws; unsigned target = 0;
  phase0a(p, smem);
  grid.sync();
  phase0b(p, smem);
  gsync(bar, target);
  ws = launder(ws);
  { InElem e{ws}; pg8_gemm8(smem, (const bf16_t*)(ws + OFF_HBF), (const bf16_t*)(ws + OFF_WIN), NTOK, DIN_PAD, DM, e); }
  gsync(bar, target);
  phase2(p);
  gsync(bar, target);
  ws = launder(ws);
  { EpiQ e{ws}; gemm_phase((const bf16_t*)(ws + OFF_ZQ), 384, (const bf16_t*)(ws + OFF_WUQ), 384, NTOK, 768, 384, smem, e); }
  ws = launder(ws);
  { EpiKV e{ws}; gemm_phase((const bf16_t*)(ws + OFF_ZKV), 256, (const bf16_t*)(ws + OFF_WUKV), 256, NTOK, 1024, 256, smem, e); }
  gsync(bar, target);
  for (int it = blockIdx.x; it < 256; it += gridDim.x) scan_item(p, it, smem);
  for (int it = blockIdx.x; it < 2048; it += gridDim.x) attn_item(p, it, smem);
  gsync(bar, target);
  ws = launder(ws);
  { EpiG8 e{ws, p.rw_lnx_g, p.rw_lnx_b}; gemm_phase<EpiG8, true>((const bf16_t*)(ws + OFF_SG), 128, (const bf16_t*)(ws + OFF_WG2), 128, NTOK, 512, 128, smem, e); }
  gsync(bar, target);
  ws = launder(ws);
  { MixElem e{(const bf16_t*)(ws + OFF_GA), (bf16_t*)(ws + OFF_MIXED), 0}; pg8_gemm8(smem, (const bf16_t*)(ws + OFF_YRW), (const bf16_t*)(ws + OFF_WBR1), NTOK, DM, 512, e); }
  ws = launder(ws);
  { MixElem e{(const bf16_t*)(ws + OFF_GB), (bf16_t*)(ws + OFF_MIXED), 1}; pg8_gemm8(smem, (const bf16_t*)(ws + OFF_YMLA), (const bf16_t*)(ws + OFF_WBR2), NTOK, DM, 512, e); }
  gsync(bar, target);
  ws = launder(ws);
  { T1bElem e{p.x, (const float*)(ws + OFF_MOD) + 2048, (bf16_t*)(ws + OFF_T1)}; pg8_gemm8(smem, (const bf16_t*)(ws + OFF_MIXED), (const bf16_t*)(ws + OFF_WOUT), NTOK, DM, DM, e); }
  gsync(bar, target);
  ws = launder(ws);
  ln1_phase((const bf16_t*)(ws + OFF_T1), (float*)(ws + OFF_RSQ), p.ln1_g, p.ln1_b, (const float*)(ws + OFF_MOD), (bf16_t*)(ws + OFF_HBF));
  gsync(bar, target);
  ws = launder(ws);
  { Relu2Elem e{(bf16_t*)(ws + OFF_HID)}; pg8_gemm8(smem, (const bf16_t*)(ws + OFF_HBF), (const bf16_t*)(ws + OFF_WFF1), NTOK, DFF, DM, e); }
  gsync(bar, target);
  ws = launder(ws);
  { Res2bElem e{(const bf16_t*)(ws + OFF_T1), (const float*)(ws + OFF_RSQ), p.ln1_g, p.ln1_b, (const float*)(ws + OFF_MOD) + 5120, p.out}; pg8_gemm8(smem, (const bf16_t*)(ws + OFF_HID), (const bf16_t*)(ws + OFF_WFF2), NTOK, DM, DFF, e); }
  gsync(bar, target);
  ln_phase<false>(p.out, p.out, p.ln2_g, p.ln2_b, nullptr, nullptr);
}

extern "C" void kernel_launch(void* const* d_in, const int* in_sizes, int n_in, void* d_out, int out_size, void* d_ws, size_t ws_size, hipStream_t stream) {
  static int grid_blocks = 0;
  if (!grid_blocks) {
    int dev = 0, cus = 0, per_cu = 0;
    hipGetDevice(&dev);
    hipDeviceGetAttribute(&cus, hipDeviceAttributeMultiprocessorCount, dev);
    hipOccupancyMaxActiveBlocksPerMultiprocessor(&per_cu, fwd_mega, 512, 0);
    if (per_cu > 1) per_cu = 1;
    if (per_cu < 1) per_cu = 1;
    grid_blocks = cus * per_cu;
  }
  Params p{};
  p.x = (const float*)d_in[0]; p.c = (const float*)d_in[1]; p.pos = (const int*)d_in[2];
  p.w_ada = (const float*)d_in[3]; p.b_ada = (const float*)d_in[4]; p.w_in = (const float*)d_in[5]; p.rw_conv = (const float*)d_in[6];
  p.rw_w0 = (const float*)d_in[7]; p.rw_w2 = (const float*)d_in[8]; p.rw_a0 = (const float*)d_in[9]; p.rw_a2 = (const float*)d_in[10];
  p.rw_k_k = (const float*)d_in[11]; p.rw_k_a = (const float*)d_in[12]; p.rw_r_k = (const float*)d_in[13]; p.rw_g2 = (const float*)d_in[14];
  p.rw_lnx_g = (const float*)d_in[15]; p.rw_lnx_b = (const float*)d_in[16]; p.q_norm_g = (const float*)d_in[17]; p.kv_norm_g = (const float*)d_in[18];
  p.w_uq = (const float*)d_in[19]; p.w_ukv = (const float*)d_in[20]; p.w_br_rwkv = (const float*)d_in[21]; p.w_br_mla = (const float*)d_in[22];
  p.w_out = (const float*)d_in[23]; p.ln1_g = (const float*)d_in[24]; p.ln1_b = (const float*)d_in[25]; p.w_ff1 = (const float*)d_in[26];
  p.w_ff2 = (const float*)d_in[27]; p.ln2_g = (const float*)d_in[28]; p.ln2_b = (const float*)d_in[29];
  p.out = (float*)d_out; p.ws = (char*)d_ws;
  hipMemsetAsync(d_ws, 0, 256, stream);
  void* args[] = {&p};
  hipError_t e = hipLaunchCooperativeKernel((void*)fwd_mega, dim3(grid_blocks), dim3(512), args, 0, stream);
  if (e != hipSuccess) fprintf(stderr, "cooperative launch failed: %s (grid %d)\n", hipGetErrorString(e), grid_blocks);
}
```

```cpp
#include <hip/hip_runtime.h>
#include <hip/hip_cooperative_groups.h>
#include <stdint.h>
#include <stdio.h>
namespace cg = cooperative_groups;

#define DI __device__ __forceinline__
typedef unsigned short bf16_t;
typedef short bf16x8 __attribute__((ext_vector_type(8)));
typedef float f32x2 __attribute__((ext_vector_type(2)));
typedef float f32x4 __attribute__((ext_vector_type(4)));
typedef float f32x16 __attribute__((ext_vector_type(16)));
typedef unsigned u32x2 __attribute__((ext_vector_type(2)));
typedef unsigned u32x4 __attribute__((ext_vector_type(4)));
typedef __bf16 bf16x2_t __attribute__((ext_vector_type(2)));

constexpr int NB = 32, SEQ = 2048, DM = 1024, NTOK = NB * SEQ;
constexpr int DIN = 4640, DIN_PAD = 4864, DFF = 4096;
constexpr int NTHR = 512;
constexpr float DN_ALPHA = 1.189207115002721f;
constexpr size_t MiB = 1u << 20;
constexpr size_t OFF_MOD = 1 * MiB, OFF_PART = 512 * MiB, OFF_WIN = 8 * MiB, OFF_WFF1 = 18 * MiB, OFF_WFF2 = 26 * MiB, OFF_WOUT = 34 * MiB,
                 OFF_WBR1 = 36 * MiB, OFF_WBR2 = 37 * MiB, OFF_WUQ = 38 * MiB, OFF_WUKV = 39 * MiB, OFF_WW2 = 40 * MiB, OFF_WA2 = 40 * MiB + 262144,
                 OFF_WG2 = 40 * MiB + 524288, OFF_RSQ = 41 * MiB, OFF_RSKV = 41 * MiB + 524288, OFF_KINV = 42 * MiB, OFF_RKDOT = 44 * MiB, OFF_CS = 46 * MiB;
constexpr size_t OFF_HBF = 56 * MiB, OFF_TW = 56 * MiB, OFF_ZA = 72 * MiB, OFF_SG = 88 * MiB, OFF_YF = 104 * MiB;
constexpr size_t OFF_ZRW = 184 * MiB, OFF_Q = 184 * MiB, OFF_KN = 280 * MiB, OFF_VT = 344 * MiB, OFF_MIXED = 184 * MiB, OFF_HID = 184 * MiB;
constexpr size_t OFF_ZQ = 424 * MiB, OFF_ZKV = 472 * MiB, OFF_ZKR = 504 * MiB, OFF_KPE = 508 * MiB, OFF_YB = 424 * MiB;
constexpr size_t OFF_GA = 512 * MiB, OFF_GB = 640 * MiB;
constexpr size_t OFF_R = 768 * MiB, OFF_K = 832 * MiB, OFF_V = 896 * MiB, OFF_YRW = 768 * MiB, OFF_YMLA = 960 * MiB, OFF_T1 = 768 * MiB;

struct Params {
  const float *x, *c; const int* pos;
  const float *w_ada, *b_ada, *w_in, *rw_conv, *rw_w0, *rw_w2, *rw_a0, *rw_a2, *rw_k_k, *rw_k_a, *rw_r_k, *rw_g2, *rw_lnx_g, *rw_lnx_b,
      *q_norm_g, *kv_norm_g, *w_uq, *w_ukv, *w_br_rwkv, *w_br_mla, *w_out, *ln1_g, *ln1_b, *w_ff1, *w_ff2, *ln2_g, *ln2_b;
  float* out; char* ws;
};

DI unsigned pk2(float lo, float hi) { f32x2 v = {lo, hi}; bf16x2_t b = __builtin_convertvector(v, bf16x2_t); return __builtin_bit_cast(unsigned, b); }
DI unsigned short f2bf(float f) { return (unsigned short)(pk2(f, 0.f) & 0xffffu); }
DI float bf2f(unsigned short b) { return __uint_as_float(((unsigned)b) << 16); }
DI float bflo(unsigned u) { return __uint_as_float(u << 16); }
DI float bfhi(unsigned u) { return __uint_as_float(u & 0xffff0000u); }
DI float sigm(float x) { return 1.f / (1.f + __expf(-x)); }
template <int CTRL> DI float dppf(float x) { return __int_as_float(__builtin_amdgcn_update_dpp(0, __float_as_int(x), CTRL, 0xf, 0xf, true)); }
DI int tidx() { int t = __builtin_amdgcn_workitem_id_x(); asm volatile("" : "+v"(t)); return t; }
DI char* launder(char* p) { asm volatile("" : "+s"(p)); return p; }
DI float fma_s(float a, float b, float c) { float d; asm("v_fma_f32 %0, %1, %2, %3" : "=v"(d) : "v"(a), "v"(b), "v"(c)); return d; }
DI float mul_s(float a, float b) { float d; asm("v_mul_f32 %0, %1, %2" : "=v"(d) : "v"(a), "v"(b)); return d; }
DI float quad_sum(float x) { x += dppf<0xB1>(x); x += dppf<0x4E>(x); return x; }

DI void mod_partial_item(const Params& p, int item, char* smem) {
  const int nt = item % 24, kc = item / 24, tid = tidx(), k0 = kc * 128;
  float* sc = (float*)smem;
  for (int i = 0; i < 8; ++i) { const int idx = tid + 512 * i, b = idx >> 7, kk = idx & 127; const float v = p.c[b * DM + k0 + kk]; sc[kk * 32 + b] = v / (1.f + __expf(-v)); }
  __syncthreads();
  float acc[32];
#pragma unroll
  for (int b = 0; b < 32; ++b) acc[b] = 0.f;
  const int n = nt * 256 + (tid & 255), kh = (tid >> 8) * 64;
#pragma unroll 8
  for (int kk = kh; kk < kh + 64; ++kk) {
    const float w = p.w_ada[(size_t)(k0 + kk) * 6144 + n];
    const f32x4* s4 = (const f32x4*)(sc + kk * 32);
#pragma unroll
    for (int q = 0; q < 8; ++q) { const f32x4 s = s4[q]; acc[4 * q] += w * s[0]; acc[4 * q + 1] += w * s[1]; acc[4 * q + 2] += w * s[2]; acc[4 * q + 3] += w * s[3]; }
  }
  float* part = (float*)(p.ws + OFF_PART) + (size_t)(kc * 2 + (tid >> 8)) * 32 * 6144;
#pragma unroll
  for (int b = 0; b < 32; ++b) part[b * 6144 + n] = acc[b];
  __syncthreads();
}

DI void transpose_tile(const float* __restrict__ src, int N, bf16_t* dst, int ldd, int kt, int nt, const float* __restrict__ rowscale, int Nvalid, char* smem) {
  float* tile = (float*)smem;
  const int tid = tidx(), k0 = kt * 64, n0 = nt * 64, nn = tid & 63;
#pragma unroll
  for (int i = 0; i < 8; ++i) {
    const int kk = i * 8 + (tid >> 6);
    float v = 0.f;
    if (n0 + nn < Nvalid) { v = src[(size_t)(k0 + kk) * N + n0 + nn]; if (rowscale) v *= rowscale[k0 + kk]; }
    tile[kk * 65 + nn] = v;
  }
  __syncthreads();
  const int n = tid >> 3, kc = (tid & 7) * 8;
  unsigned w[4];
#pragma unroll
  for (int j = 0; j < 4; ++j) w[j] = pk2(tile[(kc + 2 * j) * 65 + n], tile[(kc + 2 * j + 1) * 65 + n]);
  bf16_t* d = dst + (size_t)(n0 + n) * ldd + k0 + kc;
  *(u32x4*)d = (u32x4){w[0], w[1], w[2], w[3]};
  __syncthreads();
}

DI void conv_item(const float* __restrict__ src, int N, bf16_t* dst, int ldd, int nb, int kc, const float* __restrict__ rowscale, int Nvalid, int Npad) {
  const int n = nb * 512 + tidx(), k0 = kc * 8;
  if (n >= Npad) return;
  float v[8];
#pragma unroll
  for (int j = 0; j < 8; ++j) v[j] = (n < Nvalid) ? src[(size_t)(k0 + j) * N + n] : 0.f;
  if (rowscale) {
#pragma unroll
    for (int j = 0; j < 8; ++j) v[j] *= rowscale[k0 + j];
  }
  *(u32x4*)(dst + (size_t)n * ldd + k0) = (u32x4){pk2(v[0], v[1]), pk2(v[2], v[3]), pk2(v[4], v[5]), pk2(v[6], v[7])};
}
DI void phase0a(const Params& p, char* smem) {
  char* ws = launder(p.ws);
  constexpr int N_MOD = 192;
  constexpr int T_IN = 10 * 128, T_FF1 = 8 * 128, T_FF2 = 2 * 512, T_OUT = 2 * 128, T_BR = 2 * 64, T_UQ = 2 * 48, T_UKV = 2 * 32, T_L = 8, T_G2 = 16;
  constexpr int E0 = N_MOD, E1 = E0 + T_IN, E2 = E1 + T_FF1, E3 = E2 + T_FF2, E4 = E3 + T_OUT, E5 = E4 + T_BR, E6 = E5 + T_BR, E7 = E6 + T_UQ, E8 = E7 + T_UKV,
                E9 = E8 + 2 * T_L, E10 = E9 + 2 * T_L, E11 = E10 + T_G2;
  for (int it = blockIdx.x; it < E11; it += gridDim.x) {
    if (it < E0) mod_partial_item(p, it, smem);
    else if (it < E1) { const int t = it - E0; conv_item(p.w_in, DIN, (bf16_t*)(ws + OFF_WIN), 1024, t % 10, t / 10, nullptr, DIN, DIN_PAD); }
    else if (it < E2) { const int t = it - E1; conv_item(p.w_ff1, DFF, (bf16_t*)(ws + OFF_WFF1), 1024, t % 8, t / 8, nullptr, DFF, DFF); }
    else if (it < E3) { const int t = it - E2; conv_item(p.w_ff2, DM, (bf16_t*)(ws + OFF_WFF2), DFF, t % 2, t / 2, nullptr, DM, DM); }
    else if (it < E4) { const int t = it - E3; conv_item(p.w_out, DM, (bf16_t*)(ws + OFF_WOUT), DM, t % 2, t / 2, nullptr, DM, DM); }
    else if (it < E5) { const int t = it - E4; conv_item(p.w_br_rwkv, DM, (bf16_t*)(ws + OFF_WBR1), 512, t % 2, t / 2, nullptr, DM, DM); }
    else if (it < E6) { const int t = it - E5; conv_item(p.w_br_mla, DM, (bf16_t*)(ws + OFF_WBR2), 512, t % 2, t / 2, nullptr, DM, DM); }
    else if (it < E7) { const int t = it - E6; conv_item(p.w_uq, 768, (bf16_t*)(ws + OFF_WUQ), 384, t % 2, t / 2, p.q_norm_g, 768, 768); }
    else if (it < E8) { const int t = it - E7; conv_item(p.w_ukv, 1024, (bf16_t*)(ws + OFF_WUKV), 256, t % 2, t / 2, p.kv_norm_g, 1024, 1024); }
    else if (it < E9) { const int t = it - E8, d = t / 8; conv_item(p.rw_w2 + d * 64 * 512, 512, (bf16_t*)(ws + OFF_WW2) + d * 512 * 64, 64, 0, t % 8, nullptr, 512, 512); }
    else if (it < E10) { const int t = it - E9, d = t / 8; conv_item(p.rw_a2 + d * 64 * 512, 512, (bf16_t*)(ws + OFF_WA2) + d * 512 * 64, 64, 0, t % 8, nullptr, 512, 512); }
    else { const int t = it - E10; conv_item(p.rw_g2, 512, (bf16_t*)(ws + OFF_WG2), 128, 0, t, nullptr, 512, 512); }
  }
}

DI void phase0b(const Params& p, char* smem) {
  const float* part = (const float*)(p.ws + OFF_PART);
  float* mod = (float*)(p.ws + OFF_MOD);
  const int tid = tidx();
  for (int m = blockIdx.x; m < 192; m += gridDim.x) {
    const int b = m / 6, seg = m % 6, col = seg * 1024 + (tid & 255) * 4;
    f32x4 v = *(const f32x4*)(p.b_ada + col);
    for (int kc = 0; kc < 16; ++kc) v += *(const f32x4*)(part + ((size_t)kc * 32 + b) * 6144 + col);
    if (tid < 256) *(f32x4*)(mod + b * 6144 + col) = v;
  }
  bf16_t* hbf = (bf16_t*)(p.ws + OFF_HBF);
  for (int t = blockIdx.x; t < NTOK / 128; t += gridDim.x) {
    const int row0 = t * 128, b = row0 / SEQ, col = (tid & 255) * 4;
    f32x4 sh = *(const f32x4*)(p.b_ada + col), sc = *(const f32x4*)(p.b_ada + 1024 + col);
    for (int kc = 0; kc < 16; ++kc) { const float* pp = part + ((size_t)kc * 32 + b) * 6144 + col; sh += *(const f32x4*)pp; sc += *(const f32x4*)(pp + 1024); }
    sc += 1.f;
#pragma unroll 8
    for (int r = tid >> 8; r < 128; r += 2) {
      const f32x4 xv = *(const f32x4*)(p.x + (size_t)(row0 + r) * DM + col);
      const f32x4 h = xv * sc + sh;
      *(u32x2*)(hbf + (size_t)(row0 + r) * DM + col) = (u32x2){pk2(h[0], h[1]), pk2(h[2], h[3])};
    }
  }
}

typedef __attribute__((address_space(3))) unsigned lds_u32_t;
DI void dma16(const void* g, char* l) { __builtin_amdgcn_global_load_lds((const unsigned*)g, (lds_u32_t*)l, 16, 0, 0); }
constexpr int MI = 8;
constexpr int GSTAGE = 32768;
template <bool PERMB = false>
DI void gemm_tile_acc(f32x4 (&acc)[MI][4], const bf16_t* A, int lda, const bf16_t* Bt, int ldb, int m0, int n0, int K, char* smem) {
  const int tid = tidx(), lane = tid & 63, wid = __builtin_amdgcn_readfirstlane(tid >> 6), wm = wid >> 2, wn = wid & 3;
  const int lr = lane >> 2, lch = (lane & 3) ^ ((lane >> 3) & 3);
  const bf16_t* Ag = A + (size_t)(m0 + wid * 32 + lr) * lda + lch * 8;
  const int brow = PERMB ? (8 * (lr >> 2) + (lr & 3)) : lr, bstep = PERMB ? 4 : 16;
  const bf16_t* Bg = Bt + (size_t)(n0 + wid * 32 + brow) * ldb + lch * 8;
  const int nk = K >> 5;
  const int fch = ((lane >> 4) ^ ((lane >> 1) & 3)) << 4;
  const int abase = (wm * 128 + (lane & 15)) * 64 + fch, bbase = 16384 + (wn * 64 + (lane & 15)) * 64 + fch;
  char* swa = smem + wid * 2048;
  char* swb = smem + 16384 + wid * 2048;
#define GEMM_ISSUE(kt_, st_) do { char* da_ = swa + (st_) * GSTAGE; char* db_ = swb + (st_) * GSTAGE; \
    _Pragma("unroll") for (int i_ = 0; i_ < 2; ++i_) dma16(Ag + (size_t)i_ * 16 * lda + (kt_) * 32, da_ + i_ * 1024); \
    _Pragma("unroll") for (int i_ = 0; i_ < 2; ++i_) dma16(Bg + (size_t)i_ * bstep * ldb + (kt_) * 32, db_ + i_ * 1024); } while (0)
  GEMM_ISSUE(0, 0);
  if (nk > 1) GEMM_ISSUE(1, 1);
  int st = 0, st2 = 2;
  for (int kt = 0; kt < nk; ++kt) {
    if (kt + 1 < nk) asm volatile("s_waitcnt vmcnt(4)" ::: "memory"); else asm volatile("s_waitcnt vmcnt(0)" ::: "memory");
    __builtin_amdgcn_s_barrier();
    asm volatile("" ::: "memory");
    const bool issue = kt + 2 < nk;
    char* da = swa + st2 * GSTAGE; char* db = swb + st2 * GSTAGE;
    const bf16_t* ga_ = Ag + (kt + 2) * 32; const bf16_t* gb_ = Bg + (kt + 2) * 32;
    const char* sp = smem + st * GSTAGE;
    bf16x8 bfr[4];
#pragma unroll
    for (int i = 0; i < 4; ++i) bfr[i] = *(const bf16x8*)(sp + bbase + i * 1024);
#pragma unroll
    for (int hf = 0; hf < 2; ++hf) {
      bf16x8 af[4];
#pragma unroll
      for (int i = 0; i < 4; ++i) af[i] = *(const bf16x8*)(sp + abase + (hf * 4 + i) * 1024);
#pragma unroll
      for (int mi = 0; mi < 4; ++mi) {
#pragma unroll
        for (int ni = 0; ni < 4; ++ni) acc[hf * 4 + mi][ni] = __builtin_amdgcn_mfma_f32_16x16x32_bf16(bfr[ni], af[mi], acc[hf * 4 + mi][ni], 0, 0, 0);
        const int pc = hf * 4 + mi;
        if (issue) { if (pc == 0 || pc == 2) dma16(ga_ + (size_t)(pc >> 1) * 16 * lda, da + (pc >> 1) * 1024); else if (pc == 4 || pc == 6) dma16(gb_ + (size_t)((pc - 4) >> 1) * bstep * ldb, db + ((pc - 4) >> 1) * 1024); }
      }
    }
    st = (st == 2) ? 0 : st + 1; st2 = (st2 == 2) ? 0 : st2 + 1;
  }
  asm volatile("s_waitcnt lgkmcnt(0)" ::: "memory");
  __builtin_amdgcn_s_barrier();
  asm volatile("" ::: "memory");
#undef GEMM_ISSUE
}
DI void zero_acc(f32x4 (&acc)[MI][4]) {
#pragma unroll
  for (int i = 0; i < MI; ++i)
#pragma unroll
    for (int j = 0; j < 4; ++j) acc[i][j] = (f32x4){0.f, 0.f, 0.f, 0.f};
}

template <class Epi, bool PERMB = false>
DI void gemm_phase(const bf16_t* A, int lda, const bf16_t* Bt, int ldb, int M, int N, int K, char* smem, const Epi& epi) {
  const int nN = N / 256, nT = (M / 256) * nN;
  const int lane = tidx() & 63, wid = tidx() >> 6;
  const int xg = blockIdx.x & 7, jg = blockIdx.x >> 3, per = gridDim.x >> 3;
  for (int t0 = 0; t0 < nT; t0 += gridDim.x) {
    int t = t0 + xg * per + jg;
    if (nN == 16 && gridDim.x == 256) { const int tmr = (xg >> 1) * 4 + (jg >> 3), tnr = (xg & 1) * 8 + (jg & 7); t = t0 + tmr * 16 + tnr; }
    if (t >= nT) continue;
    const int m0 = (t / nN) * 256, n0 = (t % nN) * 256;
    f32x4 acc[MI][4];
    zero_acc(acc);
    gemm_tile_acc<PERMB>(acc, A, lda, Bt, ldb, m0, n0, K, smem);
    epi(acc, m0 + (wid >> 2) * 128, n0 + (wid & 3) * 64, lane);
  }
}

struct EpiIn {
  char* ws;
  DI void operator()(f32x4 (&acc)[MI][4], int rb, int cb, int lane) const {
    bf16_t *zrw = (bf16_t*)(ws + OFF_ZRW), *zq = (bf16_t*)(ws + OFF_ZQ), *zkv = (bf16_t*)(ws + OFF_ZKV), *zkr = (bf16_t*)(ws + OFF_ZKR), *ga = (bf16_t*)(ws + OFF_GA), *gb = (bf16_t*)(ws + OFF_GB);
#pragma unroll
    for (int ni = 0; ni < 4; ++ni) {
      const int col = cb + ni * 16 + (lane >> 4) * 4;
      if (col >= DIN) continue;
#pragma unroll
      for (int mi = 0; mi < MI; ++mi) {
        int row_ = rb + mi * 16 + (lane & 15); asm volatile("" : "+v"(row_));
        const size_t row = row_;
        f32x4 v = acc[mi][ni];
        bf16_t* d;
        if (col < 1920) d = zrw + row * 1920 + col;
        else if (col < 2304) d = zq + row * 384 + (col - 1920);
        else if (col < 2560) d = zkv + row * 256 + (col - 2304);
        else if (col < 2592) d = zkr + row * 32 + (col - 2560);
        else {
          v = (f32x4){sigm(v[0]), sigm(v[1]), sigm(v[2]), sigm(v[3])};
          d = (col < 3616) ? ga + row * 1024 + (col - 2592) : gb + row * 1024 + (col - 3616);
        }
        *(u32x2*)d = (u32x2){pk2(v[0], v[1]), pk2(v[2], v[3])};
      }
    }
  }
};

constexpr float QSCALE = 0.10206207261596577f * 1.4426950408889634f;
struct EpiQ {
  char* ws;
  DI void operator()(f32x4 (&acc)[MI][4], int rb, int cb, int lane) const {
    bf16_t* Q = (bf16_t*)(ws + OFF_Q); const float* rsq = (const float*)(ws + OFF_RSQ); const float* cs = (const float*)(ws + OFF_CS);
#pragma unroll
    for (int mi = 0; mi < MI; ++mi) {
      int row = rb + mi * 16 + (lane & 15); asm volatile("" : "+v"(row) :: "memory");
      const int b = row / SEQ, s = row % SEQ;
      const float rs = rsq[row] * QSCALE;
#pragma unroll
      for (int ni = 0; ni < 4; ++ni) {
        const int nt = (cb >> 4) + ni, h = nt / 6, sub = nt % 6;
        bf16_t* d = Q + ((size_t)(b * 8 + h) * SEQ + s) * 96;
        const int c4 = (lane >> 4) * 4;
        if (sub < 4) { const f32x4 v = acc[mi][ni] * rs; *(u32x2*)(d + sub * 16 + c4) = (u32x2){pk2(v[0], v[1]), pk2(v[2], v[3])}; }
        else if (sub == 4) {
          if (ni < 3) {
            const f32x4 x1 = acc[mi][ni] * rs, x2 = acc[mi][ni + 1 < 4 ? ni + 1 : 3] * rs;
            const f32x4 co = *(const f32x4*)(cs + (size_t)row * 32 + c4), si = *(const f32x4*)(cs + (size_t)row * 32 + 16 + c4);
            const f32x4 o1 = x1 * co - x2 * si, o2 = x1 * si + x2 * co;
            *(u32x2*)(d + 64 + c4) = (u32x2){pk2(o1[0], o1[1]), pk2(o1[2], o1[3])};
            *(u32x2*)(d + 80 + c4) = (u32x2){pk2(o2[0], o2[1]), pk2(o2[2], o2[3])};
          }
        }
      }
    }
  }
};
struct EpiKV {
  char* ws;
  DI void operator()(f32x4 (&acc)[MI][4], int rb, int cb, int lane) const {
    bf16_t* Kn = (bf16_t*)(ws + OFF_KN); bf16_t* VT = (bf16_t*)(ws + OFF_VT); const float* rskv = (const float*)(ws + OFF_RSKV);
    const int h = cb >> 7, isv = (cb >> 6) & 1;
#pragma unroll
    for (int mi = 0; mi < MI; ++mi) {
      int row = rb + mi * 16 + (lane & 15); asm volatile("" : "+v"(row) :: "memory");
      const int b = row / SEQ, s = row % SEQ;
      const float rs = rskv[row];
#pragma unroll
      for (int ni = 0; ni < 4; ++ni) {
        const int d0 = ni * 16 + (lane >> 4) * 4;
        const f32x4 v = acc[mi][ni] * rs;
        if (!isv) *(u32x2*)(Kn + ((size_t)(b * 8 + h) * SEQ + s) * 64 + d0) = (u32x2){pk2(v[0], v[1]), pk2(v[2], v[3])};
        else {
          bf16_t* d = VT + ((size_t)(b * 8 + h) * 64 + d0) * SEQ + s;
          d[0] = f2bf(v[0]); d[SEQ] = f2bf(v[1]); d[2 * SEQ] = f2bf(v[2]); d[3 * SEQ] = f2bf(v[3]);
        }
      }
    }
  }
};
struct EpiG {
  char* ws; const float *lnx_g, *lnx_b;
  DI void operator()(f32x4 (&acc)[MI][4], int rb, int cb, int lane) const {
    const bf16_t *yf = (const bf16_t*)(ws + OFF_YF), *yb = (const bf16_t*)(ws + OFF_YB), *V = (const bf16_t*)(ws + OFF_V);
    const float* rkdot = (const float*)(ws + OFF_RKDOT); bf16_t* yrw = (bf16_t*)(ws + OFF_YRW);
    const int h = cb >> 6;
#pragma unroll
    for (int mi = 0; mi < MI; ++mi) {
      int row_ = rb + mi * 16 + (lane & 15); asm volatile("" : "+v"(row_) :: "memory");
      const size_t row = row_;
      f32x4 y[4]; float sum = 0.f;
#pragma unroll
      for (int ni = 0; ni < 4; ++ni) {
        const size_t o = row * 512 + cb + ni * 16 + (lane >> 4) * 4;
        const u32x2 a = *(const u32x2*)(yf + o), b2 = *(const u32x2*)(yb + o);
        y[ni] = (f32x4){bflo(a[0]) + bflo(b2[0]), bfhi(a[0]) + bfhi(b2[0]), bflo(a[1]) + bflo(b2[1]), bfhi(a[1]) + bfhi(b2[1])};
        sum += (y[ni][0] + y[ni][1]) + (y[ni][2] + y[ni][3]);
      }
      sum += __shfl_xor(sum, 16); sum += __shfl_xor(sum, 32);
      const float mean = sum * (1.f / 64.f);
      float q = 0.f;
#pragma unroll
      for (int ni = 0; ni < 4; ++ni) { const f32x4 dd = y[ni] - mean; q += (dd[0] * dd[0] + dd[1] * dd[1]) + (dd[2] * dd[2] + dd[3] * dd[3]); }
      q += __shfl_xor(q, 16); q += __shfl_xor(q, 32);
      const float rstd = rsqrtf(q * (1.f / 64.f) + 64e-5f);
      const float rk = rkdot[row * 8 + h];
#pragma unroll
      for (int ni = 0; ni < 4; ++ni) {
        const int col = cb + ni * 16 + (lane >> 4) * 4;
        const f32x4 g = *(const f32x4*)(lnx_g + col), be = *(const f32x4*)(lnx_b + col);
        const u32x2 vv = *(const u32x2*)(V + row * 512 + col);
        const f32x4 vf = (f32x4){bflo(vv[0]), bfhi(vv[0]), bflo(vv[1]), bfhi(vv[1])};
        const f32x4 o = ((y[ni] - mean) * rstd * g + be + vf * rk) * acc[mi][ni];
        *(u32x2*)(yrw + row * 512 + col) = (u32x2){pk2(o[0], o[1]), pk2(o[2], o[3])};
      }
      asm volatile("" ::: "memory");
    }
  }
};
struct EpiG8 {
  char* ws; const float *lnx_g, *lnx_b;
  DI void operator()(f32x4 (&acc)[MI][4], int rb, int cb, int lane) const {
    const bf16_t *yf = (const bf16_t*)(ws + OFF_YF), *yb = (const bf16_t*)(ws + OFF_YB), *V = (const bf16_t*)(ws + OFF_V);
    const float* rkdot = (const float*)(ws + OFF_RKDOT); bf16_t* yrw = (bf16_t*)(ws + OFF_YRW);
    const int h = cb >> 6;
#pragma unroll
    for (int mi = 0; mi < MI; ++mi) {
      int row_ = rb + mi * 16 + (lane & 15); asm volatile("" : "+v"(row_));
      const size_t row = row_;
      f32x4 y[4]; float sum = 0.f;
      u32x4 vv2[2];
#pragma unroll
      for (int pr = 0; pr < 2; ++pr) vv2[pr] = *(const u32x4*)(V + row * 512 + cb + pr * 32 + (lane >> 4) * 8);
      const float rk = rkdot[row * 8 + h];
#pragma unroll
      for (int pr = 0; pr < 2; ++pr) {
        const size_t o = row * 512 + cb + pr * 32 + (lane >> 4) * 8;
        const u32x4 a = *(const u32x4*)(yf + o), b2 = *(const u32x4*)(yb + o);
        y[2 * pr] = (f32x4){bflo(a[0]) + bflo(b2[0]), bfhi(a[0]) + bfhi(b2[0]), bflo(a[1]) + bflo(b2[1]), bfhi(a[1]) + bfhi(b2[1])};
        y[2 * pr + 1] = (f32x4){bflo(a[2]) + bflo(b2[2]), bfhi(a[2]) + bfhi(b2[2]), bflo(a[3]) + bflo(b2[3]), bfhi(a[3]) + bfhi(b2[3])};
        sum += ((y[2 * pr][0] + y[2 * pr][1]) + (y[2 * pr][2] + y[2 * pr][3])) + ((y[2 * pr + 1][0] + y[2 * pr + 1][1]) + (y[2 * pr + 1][2] + y[2 * pr + 1][3]));
      }
      sum += __shfl_xor(sum, 16); sum += __shfl_xor(sum, 32);
      const float mean = sum * (1.f / 64.f);
      float q = 0.f;
#pragma unroll
      for (int ni = 0; ni < 4; ++ni) { const f32x4 dd = y[ni] - mean; q += (dd[0] * dd[0] + dd[1] * dd[1]) + (dd[2] * dd[2] + dd[3] * dd[3]); }
      q += __shfl_xor(q, 16); q += __shfl_xor(q, 32);
      const float rstd = rsqrtf(q * (1.f / 64.f) + 64e-5f);
#pragma unroll
      for (int pr = 0; pr < 2; ++pr) {
        const int col = cb + pr * 32 + (lane >> 4) * 8;
        const u32x4 vv = vv2[pr];
        const f32x4 g0 = *(const f32x4*)(lnx_g + col), g1 = *(const f32x4*)(lnx_g + col + 4), be0 = *(const f32x4*)(lnx_b + col), be1 = *(const f32x4*)(lnx_b + col + 4);
        const f32x4 v0 = (f32x4){bflo(vv[0]), bfhi(vv[0]), bflo(vv[1]), bfhi(vv[1])}, v1 = (f32x4){bflo(vv[2]), bfhi(vv[2]), bflo(vv[3]), bfhi(vv[3])};
        const f32x4 o0 = ((y[2 * pr] - mean) * rstd * g0 + be0 + v0 * rk) * acc[mi][2 * pr];
        const f32x4 o1 = ((y[2 * pr + 1] - mean) * rstd * g1 + be1 + v1 * rk) * acc[mi][2 * pr + 1];
        *(u32x4*)(yrw + row * 512 + col) = (u32x4){pk2(o0[0], o0[1]), pk2(o0[2], o0[3]), pk2(o1[0], o1[1]), pk2(o1[2], o1[3])};
      }
      if (mi & 1) asm volatile("" ::: "memory");
    }
  }
};
struct EpiRes {
  const float* base; const float* gate; float* out;
  DI void operator()(f32x4 (&acc)[MI][4], int rb, int cb, int lane) const {
#pragma unroll
    for (int mi = 0; mi < MI; ++mi) {
      int row_ = rb + mi * 16 + (lane & 15); asm volatile("" : "+v"(row_) :: "memory");
      const size_t row = row_; const int b = (int)(row / SEQ);
#pragma unroll
      for (int ni = 0; ni < 4; ++ni) {
        const int col = cb + ni * 16 + (lane >> 4) * 4;
        const f32x4 g = *(const f32x4*)(gate + b * 6144 + col) + 1.f;
        const f32x4 xb = *(const f32x4*)(base + row * DM + col);
        *(f32x4*)(out + row * DM + col) = xb * DN_ALPHA + g * acc[mi][ni];
      }
      asm volatile("" ::: "memory");
    }
  }
};
struct EpiRelu2 {
  bf16_t* out;
  DI void operator()(f32x4 (&acc)[MI][4], int rb, int cb, int lane) const {
#pragma unroll
    for (int mi = 0; mi < MI; ++mi) {
      int row_ = rb + mi * 16 + (lane & 15); asm volatile("" : "+v"(row_) :: "memory");
      const size_t row = row_;
#pragma unroll
      for (int ni = 0; ni < 4; ++ni) {
        const int col = cb + ni * 16 + (lane >> 4) * 4;
        f32x4 v = acc[mi][ni];
#pragma unroll
        for (int j = 0; j < 4; ++j) { const float r = fmaxf(v[j], 0.f); v[j] = r * r; }
        *(u32x2*)(out + row * DFF + col) = (u32x2){pk2(v[0], v[1]), pk2(v[2], v[3])};
      }
    }
  }
};

namespace pg8 {
#define PG8_LAS __attribute__((address_space(3)))
typedef unsigned short bf16_t;
typedef short bf16x8 __attribute__((ext_vector_type(8)));
typedef float f32x4 __attribute__((ext_vector_type(4)));
typedef unsigned u32x4 __attribute__((ext_vector_type(4)));
constexpr int BM = 256, BK = 64, HALF = 128, HTB = HALF * BK * 2  , STAGE_BYTES = 8 * HTB, NXCD = 8, WGM = 8;

__host__ __device__ __forceinline__ int lds_byte(int r, int c) { const int st = (r >> 4) * 2 + (c >> 5), rr = r & 15, cc = c & 31, ob = rr * 64 + cc * 2; return st * 1024 + (ob ^ (((ob >> 9) & 1) << 5)); }
__host__ __device__ __forceinline__ void stage_rc(int b, int& R, int& C) { const int st = b / 1024, sb = b % 1024, swz = sb ^ (((sb >> 9) & 1) << 5); R = (st >> 1) * 16 + swz / 64; C = (st & 1) * 32 + (swz % 64) / 2; }
__host__ __device__ __forceinline__ int perm32(int rho) { const int n = rho >> 4, i = rho & 15; return 8 * (i >> 2) + 4 * n + (i & 3); }

struct Unit { int pm, pn; };
struct Gemm { const bf16_t* A; const bf16_t* Bt; int M, N, K; };

struct StaticOrder {
    int nM, nN, nwg, G, c;
    __host__ __device__ void init(int M, int N, int G_, int c_) { nM = M / BM; nN = N / BM; nwg = nM * nN; G = G_; c = c_; }
    __host__ __device__ bool next(int i, Unit& u) const {
        const long L = (long)i * G + c; if (L >= nwg) return false;
        int wgid = (int)L; { const int q = nwg / NXCD, r = nwg % NXCD, xcd = wgid % NXCD, off = wgid / NXCD; wgid = (xcd < r ? xcd * (q + 1) : r * (q + 1) + (xcd - r) * q) + off; }
        const int nig = WGM * nN, gid = wgid / nig, fm = gid * WGM, gsz = (nM - fm) < WGM ? (nM - fm) : WGM;
        u.pm = fm + ((wgid % nig) % gsz); u.pn = (wgid % nig) / gsz; return true;
    }
    __device__ __forceinline__ void a_ready(const Unit&) const {}
    __device__ __forceinline__ void done(const Unit&) const {}
};

template <class Epi, class Sched, bool ALIGN_EPI = false, bool SP2 = false>
__device__ __forceinline__ void gemm_phase(PG8_LAS unsigned char* lds, const Gemm g, const Sched& S, const Epi& E) {
    const int tid = ::tidx(), wid = __builtin_amdgcn_readfirstlane(tid >> 6), lane = tid & 63, wr = wid >> 2, wc = wid & 3, fr = lane & 15, fq = lane >> 4;
    const int K = g.K, nt = K / BK;
    unsigned voffA[2], voffB[2];
#pragma unroll
    for (int i = 0; i < 2; ++i) { int R, C; stage_rc(tid * 16 + i * 8192, R, C); const int Rb = Epi::PERM ? ((R & ~31) + perm32(R & 31)) : R;
        voffA[i] = (unsigned)(R * K + C) * 2u; voffB[i] = (unsigned)(Rb * K + C) * 2u; }
    const size_t kstep = (size_t)(BK * 2);
    const size_t hstep = (size_t)HALF * K * 2;
    const size_t tstep = 2 * hstep;
    const unsigned ldsw = (unsigned)wid * 1024u;
    const int aoff = lds_byte(wr * 64 + fr, fq * 8), boff = lds_byte(wc * 32 + fr, fq * 8);
#define PG8_SA(b, h) (((b) * 2 + (h)) * HTB)
#define PG8_SB(b, h) ((4 + (b) * 2 + (h)) * HTB)
#define PG8_STAGE(bufoff, gbase, voff) do { _Pragma("unroll") for (int _i = 0; _i < 2; ++_i) \
        __builtin_amdgcn_global_load_lds((const unsigned*)((const char*)(gbase) + (voff)[_i]), (PG8_LAS unsigned*)(lds + (bufoff) + ldsw + _i * 8192), 16, 0, 0); } while (0)
#define PG8_LDA(dst, b, h) do { _Pragma("unroll") for (int m = 0; m < 4; ++m) _Pragma("unroll") for (int k = 0; k < 2; ++k) dst[m][k] = *(const PG8_LAS bf16x8*)(lds + PG8_SA(b, h) + aoff + m * 2048 + k * 1024); } while (0)
#define PG8_LDB(dst, b, h) do { _Pragma("unroll") for (int n = 0; n < 2; ++n) _Pragma("unroll") for (int k = 0; k < 2; ++k) dst[n][k] = *(const PG8_LAS bf16x8*)(lds + PG8_SB(b, h) + boff + n * 2048 + k * 1024); } while (0)
#define PG8_MMA(ai, bj, At, Bt) do { __builtin_amdgcn_s_setprio(1); _Pragma("unroll") for (int m = 0; m < 4; ++m) _Pragma("unroll") for (int n = 0; n < 2; ++n) _Pragma("unroll") for (int k = 0; k < 2; ++k) \
        acc[ai][bj][m][n] = __builtin_amdgcn_mfma_f32_16x16x32_bf16(Bt[n][k], At[m][k], acc[ai][bj][m][n], 0, 0, 0); __builtin_amdgcn_s_setprio(0); } while (0)
#define PG8_WAIT_V(n) asm volatile("s_waitcnt vmcnt(" #n ")" ::: "memory")
#define PG8_WAIT_L(n) asm volatile("s_waitcnt lgkmcnt(" #n ")" ::: "memory")
#define PG8_BAR __builtin_amdgcn_s_barrier()
#define PG8_SCHED __builtin_amdgcn_sched_barrier(0)
    Unit cur, nxt; int ui = 0;
    if (!S.next(0, cur)) return;
    f32x4 acc[2][2][4][2];
#pragma unroll
    for (int a = 0; a < 2; ++a)
#pragma unroll
        for (int b = 0; b < 2; ++b)
#pragma unroll
            for (int m = 0; m < 4; ++m)
#pragma unroll
                for (int n = 0; n < 2; ++n) acc[a][b][m][n] = (f32x4){0.f, 0.f, 0.f, 0.f};
    bf16x8 At[4][2], B0[2][2], B1[2][2];
    const char* cA = (const char*)g.A + (size_t)cur.pm * tstep; const char* cB = (const char*)g.Bt + (size_t)cur.pn * tstep;
    S.a_ready(cur);
    if constexpr (SP2) {
        PG8_STAGE(PG8_SB(0, 0), cB, voffB); PG8_STAGE(PG8_SB(0, 1), cB + hstep, voffB); PG8_STAGE(PG8_SA(0, 0), cA, voffA); PG8_STAGE(PG8_SA(0, 1), cA + hstep, voffA);
        if (wr == 1) PG8_BAR;
        PG8_WAIT_V(2); PG8_BAR;
        PG8_STAGE(PG8_SB(1, 0), cB + kstep, voffB); PG8_STAGE(PG8_SA(1, 0), cA + kstep, voffA); PG8_STAGE(PG8_SB(1, 1), cB + hstep + kstep, voffB);
        PG8_WAIT_V(6); PG8_BAR;
    } else {
        PG8_STAGE(PG8_SB(0, 0), cB, voffB); PG8_STAGE(PG8_SA(0, 0), cA, voffA); PG8_STAGE(PG8_SB(0, 1), cB + hstep, voffB); PG8_STAGE(PG8_SA(0, 1), cA + hstep, voffA);
        if (wr == 1) PG8_BAR;
        PG8_WAIT_V(4); PG8_BAR;
        PG8_STAGE(PG8_SB(1, 0), cB + kstep, voffB); PG8_STAGE(PG8_SA(1, 0), cA + kstep, voffA); PG8_STAGE(PG8_SB(1, 1), cB + hstep + kstep, voffB);
        PG8_WAIT_V(6); PG8_BAR;
    }
    for (;;) {
        const bool has_next = S.next(ui + 1, nxt);
        const char* nA = has_next ? (const char*)g.A + (size_t)nxt.pm * tstep : cA; const char* nB = has_next ? (const char*)g.Bt + (size_t)nxt.pn * tstep : cB;
        for (int t = 0; t < nt; t += 2) {
            const bool last = (t == nt - 2);
            const char* a1 = cA + (size_t)(t + 1) * kstep;
            const char* a2 = last ? nA : cA + (size_t)(t + 2) * kstep; const char* b2 = last ? nB : cB + (size_t)(t + 2) * kstep;
            const char* a3 = a2 + kstep; const char* b3 = b2 + kstep;
            if (last && has_next) S.a_ready(nxt);
            if constexpr (SP2) {
            PG8_LDB(B0, 0, 0); PG8_LDB(B1, 0, 1); PG8_SCHED; PG8_LDA(At, 0, 0); PG8_STAGE(PG8_SA(1, 1), a1 + hstep, voffA);
            PG8_WAIT_V(8); PG8_WAIT_L(0); PG8_BAR; PG8_MMA(0, 0, At, B0); PG8_MMA(0, 1, At, B1); PG8_BAR; PG8_SCHED;
            PG8_LDA(At, 0, 1); PG8_STAGE(PG8_SB(0, 0), b2, voffB); PG8_STAGE(PG8_SB(0, 1), b2 + hstep, voffB); PG8_STAGE(PG8_SA(0, 0), a2, voffA);
            PG8_WAIT_V(8); PG8_WAIT_L(0); PG8_BAR; PG8_MMA(1, 0, At, B0); PG8_MMA(1, 1, At, B1); PG8_BAR; PG8_SCHED;
            PG8_LDB(B0, 1, 0); PG8_LDB(B1, 1, 1); PG8_SCHED; PG8_LDA(At, 1, 0); PG8_STAGE(PG8_SA(0, 1), a2 + hstep, voffA);
            PG8_WAIT_V(8); PG8_WAIT_L(0); PG8_BAR; PG8_MMA(0, 0, At, B0); PG8_MMA(0, 1, At, B1); PG8_BAR; PG8_SCHED;
            PG8_LDA(At, 1, 1); PG8_STAGE(PG8_SB(1, 0), b3, voffB); PG8_STAGE(PG8_SB(1, 1), b3 + hstep, voffB); PG8_STAGE(PG8_SA(1, 0), a3, voffA);
            PG8_WAIT_V(8); PG8_WAIT_L(0); PG8_BAR; PG8_MMA(1, 0, At, B0); PG8_MMA(1, 1, At, B1); PG8_BAR; PG8_SCHED;
            } else {
            PG8_LDB(B0, 0, 0); PG8_SCHED; PG8_LDA(At, 0, 0); PG8_STAGE(PG8_SA(1, 1), a1 + hstep, voffA);
            PG8_WAIT_L(8); PG8_BAR; PG8_WAIT_L(0); PG8_MMA(0, 0, At, B0); PG8_BAR; PG8_SCHED;
            PG8_LDB(B1, 0, 1); PG8_STAGE(PG8_SB(0, 0), b2, voffB);
            PG8_BAR; PG8_WAIT_L(0); PG8_MMA(0, 1, At, B1); PG8_BAR;
            PG8_LDA(At, 0, 1); PG8_STAGE(PG8_SA(0, 0), a2, voffA);
            PG8_BAR; PG8_WAIT_L(0); PG8_MMA(1, 0, At, B0); PG8_BAR; PG8_SCHED;
            PG8_STAGE(PG8_SB(0, 1), b2 + hstep, voffB);
            PG8_WAIT_V(6); PG8_BAR; PG8_MMA(1, 1, At, B1); PG8_BAR;
            PG8_LDB(B0, 1, 0); PG8_SCHED; PG8_LDA(At, 1, 0); PG8_STAGE(PG8_SA(0, 1), a2 + hstep, voffA);
            PG8_WAIT_L(8); PG8_BAR; PG8_WAIT_L(0); PG8_MMA(0, 0, At, B0); PG8_BAR; PG8_SCHED;
            PG8_LDB(B1, 1, 1); PG8_STAGE(PG8_SB(1, 0), b3, voffB);
            PG8_BAR; PG8_WAIT_L(0); PG8_MMA(0, 1, At, B1); PG8_BAR;
            PG8_LDA(At, 1, 1); PG8_STAGE(PG8_SA(1, 0), a3, voffA);
            PG8_BAR; PG8_WAIT_L(0); PG8_MMA(1, 0, At, B0); PG8_BAR; PG8_SCHED;
            PG8_STAGE(PG8_SB(1, 1), b3 + hstep, voffB);
            PG8_WAIT_V(6); PG8_BAR; PG8_MMA(1, 1, At, B1); PG8_BAR;
            }
        }
        if constexpr (ALIGN_EPI) { if (wr == 0) PG8_BAR; }
        if constexpr (!Epi::AFTER_DRAIN) { E(acc, cur, wr, wc, fr, fq); S.done(cur); }
        if (!has_next) break;
#pragma unroll
        for (int a = 0; a < 2; ++a)
#pragma unroll
            for (int b = 0; b < 2; ++b)
#pragma unroll
                for (int m = 0; m < 4; ++m)
#pragma unroll
                    for (int n = 0; n < 2; ++n) acc[a][b][m][n] = (f32x4){0.f, 0.f, 0.f, 0.f};
        cur = nxt; cA = nA; cB = nB; ++ui;
        if constexpr (ALIGN_EPI) { if (wr == 1) PG8_BAR; }
    }
    PG8_WAIT_V(0);
    if constexpr (!ALIGN_EPI) { if (wr == 0) PG8_BAR; }
    PG8_BAR;
    if constexpr (Epi::AFTER_DRAIN) { E.fused(acc, cur, wr, wc, fr, fq, lds, wid, lane); S.done(cur); }
#undef PG8_SA
#undef PG8_SB
#undef PG8_STAGE
#undef PG8_LDA
#undef PG8_LDB
#undef PG8_MMA
#undef PG8_WAIT_V
#undef PG8_WAIT_L
#undef PG8_BAR
#undef PG8_SCHED
}
}

template <class F> struct PgEpi {
  static constexpr bool PERM = false, AFTER_DRAIN = false;
  F f;
  __device__ __forceinline__ void operator()(const pg8::f32x4 (&acc)[2][2][4][2], const pg8::Unit& u, int wr, int wc, int fr, int fq) const {
#pragma unroll
    for (int ai = 0; ai < 2; ++ai)
#pragma unroll
      for (int m = 0; m < 4; ++m) {
        int row = u.pm * 256 + ai * 128 + wr * 64 + m * 16 + fr; asm volatile("" : "+v"(row));
#pragma unroll
        for (int bj = 0; bj < 2; ++bj)
#pragma unroll
          for (int n = 0; n < 2; ++n) {
            const int col = u.pn * 256 + bj * 128 + wc * 32 + n * 16 + fq * 4;
            const pg8::f32x4 a = acc[ai][bj][m][n];
            f.elem(row, col, (f32x4){a[0], a[1], a[2], a[3]});
          }
        if (m & 1) asm volatile("" ::: "memory");
      }
  }
};
struct InElem {
  char* ws;
  DI void elem8(int row_, int col, f32x4 v, f32x4 w) const {
    if (col >= DIN) return;
    const size_t row = row_;
    bf16_t* d;
    if (col < 1920) d = (bf16_t*)(ws + OFF_ZRW) + row * 1920 + col;
    else if (col < 2304) d = (bf16_t*)(ws + OFF_ZQ) + row * 384 + (col - 1920);
    else if (col < 2560) d = (bf16_t*)(ws + OFF_ZKV) + row * 256 + (col - 2304);
    else if (col < 2592) d = (bf16_t*)(ws + OFF_ZKR) + row * 32 + (col - 2560);
    else {
      v = (f32x4){sigm(v[0]), sigm(v[1]), sigm(v[2]), sigm(v[3])}; w = (f32x4){sigm(w[0]), sigm(w[1]), sigm(w[2]), sigm(w[3])};
      d = (col < 3616) ? (bf16_t*)(ws + OFF_GA) + row * 1024 + (col - 2592) : (bf16_t*)(ws + OFF_GB) + row * 1024 + (col - 3616);
    }
    *(u32x4*)d = (u32x4){pk2(v[0], v[1]), pk2(v[2], v[3]), pk2(w[0], w[1]), pk2(w[2], w[3])};
  }
  DI void elem(int row_, int col, f32x4 v) const {
    if (col >= DIN) return;
    const size_t row = row_;
    bf16_t* d;
    if (col < 1920) d = (bf16_t*)(ws + OFF_ZRW) + row * 1920 + col;
    else if (col < 2304) d = (bf16_t*)(ws + OFF_ZQ) + row * 384 + (col - 1920);
    else if (col < 2560) d = (bf16_t*)(ws + OFF_ZKV) + row * 256 + (col - 2304);
    else if (col < 2592) d = (bf16_t*)(ws + OFF_ZKR) + row * 32 + (col - 2560);
    else {
      v = (f32x4){sigm(v[0]), sigm(v[1]), sigm(v[2]), sigm(v[3])};
      d = (col < 3616) ? (bf16_t*)(ws + OFF_GA) + row * 1024 + (col - 2592) : (bf16_t*)(ws + OFF_GB) + row * 1024 + (col - 3616);
    }
    *(u32x2*)d = (u32x2){pk2(v[0], v[1]), pk2(v[2], v[3])};
  }
};
struct Relu2Elem {
  bf16_t* out;
  DI void elem8(int row_, int col, f32x4 v, f32x4 w) const {
#pragma unroll
    for (int j = 0; j < 4; ++j) { const float r = fmaxf(v[j], 0.f); v[j] = r * r; const float q = fmaxf(w[j], 0.f); w[j] = q * q; }
    *(u32x4*)(out + (size_t)row_ * DFF + col) = (u32x4){pk2(v[0], v[1]), pk2(v[2], v[3]), pk2(w[0], w[1]), pk2(w[2], w[3])};
  }
  DI void elem(int row_, int col, f32x4 v) const {
#pragma unroll
    for (int j = 0; j < 4; ++j) { const float r = fmaxf(v[j], 0.f); v[j] = r * r; }
    *(u32x2*)(out + (size_t)row_ * DFF + col) = (u32x2){pk2(v[0], v[1]), pk2(v[2], v[3])};
  }
};
struct ResElem {
  const float* base; const float* gate; float* out;
  DI void elem(int row_, int col, f32x4 v) const {
    const size_t row = row_; const int b = row_ / SEQ;
    const f32x4 g = *(const f32x4*)(gate + b * 6144 + col) + 1.f;
    const f32x4 xb = *(const f32x4*)(base + row * DM + col);
    *(f32x4*)(out + row * DM + col) = xb * DN_ALPHA + g * v;
  }
};
template <class F> struct PgEpi8 {
  static constexpr bool PERM = true, AFTER_DRAIN = false;
  F f;
  __device__ __forceinline__ void operator()(const pg8::f32x4 (&acc)[2][2][4][2], const pg8::Unit& u, int wr, int wc, int fr, int fq) const {
#pragma unroll
    for (int ai = 0; ai < 2; ++ai)
#pragma unroll
      for (int m = 0; m < 4; ++m) {
        int row = u.pm * 256 + ai * 128 + wr * 64 + m * 16 + fr; asm volatile("" : "+v"(row));
#pragma unroll
        for (int bj = 0; bj < 2; ++bj) {
          const int col = u.pn * 256 + bj * 128 + wc * 32 + fq * 8;
          const pg8::f32x4 a = acc[ai][bj][m][0], b = acc[ai][bj][m][1];
          f.elem8(row, col, (f32x4){a[0], a[1], a[2], a[3]}, (f32x4){b[0], b[1], b[2], b[3]});
        }
        if (m & 1) asm volatile("" ::: "memory");
      }
  }
};
struct MixElem {
  const bf16_t* gate; bf16_t* mixed; int pass;
  DI void elem8(int row_, int col, f32x4 v, f32x4 w) const {
    const size_t o = (size_t)row_ * DM + col;
    const u32x4 g = *(const u32x4*)(gate + o);
    v *= (f32x4){bflo(g[0]), bfhi(g[0]), bflo(g[1]), bfhi(g[1])}; w *= (f32x4){bflo(g[2]), bfhi(g[2]), bflo(g[3]), bfhi(g[3])};
    if (pass) { const u32x4 mm = *(const u32x4*)(mixed + o);
      v += (f32x4){bflo(mm[0]), bfhi(mm[0]), bflo(mm[1]), bfhi(mm[1])}; w += (f32x4){bflo(mm[2]), bfhi(mm[2]), bflo(mm[3]), bfhi(mm[3])}; }
    *(u32x4*)(mixed + o) = (u32x4){pk2(v[0], v[1]), pk2(v[2], v[3]), pk2(w[0], w[1]), pk2(w[2], w[3])};
  }
};
struct T1bElem {
  const float* base; const float* gate; bf16_t* out;
  DI void elem8(int row_, int col, f32x4 v, f32x4 w) const {
    const size_t row = row_; const int b = row_ / SEQ;
    const f32x4 g0 = *(const f32x4*)(gate + b * 6144 + col) + 1.f, g1 = *(const f32x4*)(gate + b * 6144 + col + 4) + 1.f;
    const f32x4 x0 = *(const f32x4*)(base + row * DM + col), x1 = *(const f32x4*)(base + row * DM + col + 4);
    const f32x4 t0 = x0 * DN_ALPHA + g0 * v, t1 = x1 * DN_ALPHA + g1 * w;
    *(u32x4*)(out + row * DM + col) = (u32x4){pk2(t0[0], t0[1]), pk2(t0[2], t0[3]), pk2(t1[0], t1[1]), pk2(t1[2], t1[3])};
  }
};
struct Res2bElem {
  const bf16_t* t1; const float* stats; const float *g1, *b1; const float* gate; float* out;
  DI void elem8(int row_, int col, f32x4 v, f32x4 w) const {
    const size_t row = row_; const int b = row_ / SEQ;
    const f32x2 st = *(const f32x2*)(stats + row * 2);
    const u32x4 tt = *(const u32x4*)(t1 + row * DM + col);
    const f32x4 ta = (f32x4){bflo(tt[0]), bfhi(tt[0]), bflo(tt[1]), bfhi(tt[1])}, tb = (f32x4){bflo(tt[2]), bfhi(tt[2]), bflo(tt[3]), bfhi(tt[3])};
    const f32x4 xa = (ta - st[0]) * st[1] * *(const f32x4*)(g1 + col) + *(const f32x4*)(b1 + col);
    const f32x4 xb = (tb - st[0]) * st[1] * *(const f32x4*)(g1 + col + 4) + *(const f32x4*)(b1 + col + 4);
    const f32x4 ga = *(const f32x4*)(gate + b * 6144 + col) + 1.f, gb = *(const f32x4*)(gate + b * 6144 + col + 4) + 1.f;
    *(f32x4*)(out + row * DM + col) = xa * DN_ALPHA + ga * v;
    *(f32x4*)(out + row * DM + col + 4) = xb * DN_ALPHA + gb * w;
  }
};
template <class F>
DI void pg8_gemm8(char* smem, const bf16_t* A, const bf16_t* Bt, int M, int N, int K, const F& f) {
  pg8::StaticOrder S; S.init(M, N, (int)gridDim.x, (int)blockIdx.x);
  PgEpi8<F> E{f};
  pg8::gemm_phase<PgEpi8<F>, pg8::StaticOrder, true, true>((PG8_LAS unsigned char*)smem, pg8::Gemm{A, Bt, M, N, K}, S, E);
}
struct Res2Elem {
  const float* t1; const float* stats; const float *g1, *b1; const float* gate; float* out;
  DI void elem(int row_, int col, f32x4 v) const {
    const size_t row = row_; const int b = row_ / SEQ;
    const f32x2 st = *(const f32x2*)(stats + row * 2);
    const f32x4 x1 = (*(const f32x4*)(t1 + row * DM + col) - st[0]) * st[1] * *(const f32x4*)(g1 + col) + *(const f32x4*)(b1 + col);
    const f32x4 g = *(const f32x4*)(gate + b * 6144 + col) + 1.f;
    *(f32x4*)(out + row * DM + col) = x1 * DN_ALPHA + g * v;
  }
};
template <class F>
DI void pg8_gemm(char* smem, const bf16_t* A, const bf16_t* Bt, int M, int N, int K, const F& f) {
  pg8::StaticOrder S; S.init(M, N, (int)gridDim.x, (int)blockIdx.x);
  PgEpi<F> E{f};
  pg8::gemm_phase<PgEpi<F>, pg8::StaticOrder, true, true>((PG8_LAS unsigned char*)smem, pg8::Gemm{A, Bt, M, N, K}, S, E);
}

DI void conv8(float (&o)[8], const bf16_t* zrow, int col, bool hp, bool hn, const float* __restrict__ cw) {
  const u32x4 zc = *(const u32x4*)(zrow + col);
  u32x4 zp = (u32x4){0, 0, 0, 0}, zn = (u32x4){0, 0, 0, 0};
  if (hp) zp = *(const u32x4*)(zrow - 1920 + col);
  if (hn) zn = *(const u32x4*)(zrow + 1920 + col);
#pragma unroll
  for (int e = 0; e < 4; ++e) {
    const f32x2 w0 = *(const f32x2*)(cw + col + 2 * e), w1 = *(const f32x2*)(cw + 1920 + col + 2 * e), w2 = *(const f32x2*)(cw + 3840 + col + 2 * e);
    o[2 * e] = w0[0] * bflo(zp[e]) + w1[0] * bflo(zc[e]) + w2[0] * bflo(zn[e]);
    o[2 * e + 1] = w0[1] * bfhi(zp[e]) + w1[1] * bfhi(zc[e]) + w2[1] * bfhi(zn[e]);
  }
}
DI void load_cw(float (&w)[24], const float* __restrict__ cw, int col) {
#pragma unroll
  for (int j = 0; j < 3; ++j)
#pragma unroll
    for (int e = 0; e < 4; ++e) { const f32x2 t = *(const f32x2*)(cw + j * 1920 + col + 2 * e); w[j * 8 + 2 * e] = t[0]; w[j * 8 + 2 * e + 1] = t[1]; }
}
DI void conv8w(float (&o)[8], const bf16_t* zrow, int col, bool hp, bool hn, const float (&w)[24]) {
  const u32x4 zc = *(const u32x4*)(zrow + col);
  u32x4 zp = (u32x4){0, 0, 0, 0}, zn = (u32x4){0, 0, 0, 0};
  if (hp) zp = *(const u32x4*)(zrow - 1920 + col);
  if (hn) zn = *(const u32x4*)(zrow + 1920 + col);
#pragma unroll
  for (int e = 0; e < 4; ++e) {
    o[2 * e] = w[2 * e] * bflo(zp[e]) + w[8 + 2 * e] * bflo(zc[e]) + w[16 + 2 * e] * bflo(zn[e]);
    o[2 * e + 1] = w[2 * e + 1] * bfhi(zp[e]) + w[8 + 2 * e + 1] * bfhi(zc[e]) + w[16 + 2 * e + 1] * bfhi(zn[e]);
  }
}
DI u32x4 pack8(const float (&o)[8]) { return (u32x4){pk2(o[0], o[1]), pk2(o[2], o[3]), pk2(o[4], o[5]), pk2(o[6], o[7])}; }

struct ZL3 { u32x4 c, p, n; };
DI void load_z3(ZL3& z, const bf16_t* zrow, int col, bool hp, bool hn) {
  z.c = *(const u32x4*)(zrow + col);
  z.p = (u32x4){0, 0, 0, 0}; z.n = (u32x4){0, 0, 0, 0};
  if (hp) z.p = *(const u32x4*)(zrow - 1920 + col);
  if (hn) z.n = *(const u32x4*)(zrow + 1920 + col);
}
DI void conv_z3(float (&o)[8], const ZL3& z, const float (&w)[24]) {
#pragma unroll
  for (int e = 0; e < 4; ++e) {
    o[2 * e] = w[2 * e] * bflo(z.p[e]) + w[8 + 2 * e] * bflo(z.c[e]) + w[16 + 2 * e] * bflo(z.n[e]);
    o[2 * e + 1] = w[2 * e + 1] * bfhi(z.p[e]) + w[8 + 2 * e + 1] * bfhi(z.c[e]) + w[16 + 2 * e + 1] * bfhi(z.n[e]);
  }
}
DI void phase2(const Params& p) {
  char* ws = launder(p.ws);
  const bf16_t* zrw = (const bf16_t*)(ws + OFF_ZRW);
  bf16_t *R = (bf16_t*)(ws + OFF_R), *K = (bf16_t*)(ws + OFF_K), *V = (bf16_t*)(ws + OFF_V), *TW = (bf16_t*)(ws + OFF_TW), *ZA = (bf16_t*)(ws + OFF_ZA), *SG = (bf16_t*)(ws + OFF_SG);
  float *kinv = (float*)(ws + OFF_KINV), *rkdot = (float*)(ws + OFF_RKDOT), *rsq = (float*)(ws + OFF_RSQ), *rskv = (float*)(ws + OFF_RSKV), *cs = (float*)(ws + OFF_CS);
  const bf16_t *zq = (const bf16_t*)(ws + OFF_ZQ), *zkv = (const bf16_t*)(ws + OFF_ZKV), *zkr = (const bf16_t*)(ws + OFF_ZKR);
  bf16_t* kpe = (bf16_t*)(ws + OFF_KPE);
  const int lane = tidx() & 63, wid = tidx() >> 6;
  const float invf = powf(10000.f, -(float)(lane & 15) * (1.f / 16.f));
  float cwr[24], cwk[24], cwv[24], kkw[8], rkw[8];
  load_cw(cwr, p.rw_conv, 8 * lane); load_cw(cwk, p.rw_conv, 512 + 8 * lane); load_cw(cwv, p.rw_conv, 1024 + 8 * lane);
  float cwx[24];
  load_cw(cwx, p.rw_conv, 1536 + 8 * (lane < 48 ? lane : 0));
#pragma unroll
  for (int e = 0; e < 8; ++e) { kkw[e] = p.rw_k_k[8 * lane + e]; rkw[e] = p.rw_r_k[8 * lane + e]; }
  const int l47 = lane < 48 ? lane : 47, l31 = lane & 31, l15 = lane & 15;
  for (int tok = blockIdx.x * 8 + wid; tok < NTOK; tok += gridDim.x * 8) {
    const int s = tok % SEQ; const bool hp = s > 0, hn = s < SEQ - 1;
    const bf16_t* zrow = zrw + (size_t)tok * 1920;
    ZL3 zr, zk, zv, zx;
    load_z3(zr, zrow, 8 * lane, hp, hn); load_z3(zk, zrow, 512 + 8 * lane, hp, hn); load_z3(zv, zrow, 1024 + 8 * lane, hp, hn);
    load_z3(zx, zrow, 1536 + 8 * l47, hp, hn);
    const u32x4 zqv = *(const u32x4*)(zq + (size_t)tok * 384 + 8 * l47);
    const u32x4 zkvv = *(const u32x4*)(zkv + (size_t)tok * 256 + 8 * l31);
    const unsigned short kr1 = zkr[(size_t)tok * 32 + l15], kr2 = zkr[(size_t)tok * 32 + 16 + l15];
    const int posv = p.pos[tok];
    float r8[8], k8[8], v8[8];
    conv_z3(r8, zr, cwr); conv_z3(k8, zk, cwk); conv_z3(v8, zv, cwv);
    *(u32x4*)(R + (size_t)tok * 512 + 8 * lane) = pack8(r8);
    *(u32x4*)(K + (size_t)tok * 512 + 8 * lane) = pack8(k8);
    *(u32x4*)(V + (size_t)tok * 512 + 8 * lane) = pack8(v8);
    float ss = 0.f, rk = 0.f;
#pragma unroll
    for (int e = 0; e < 8; ++e) { const float kk = k8[e] * kkw[e]; ss += kk * kk; rk += r8[e] * k8[e] * rkw[e]; }
    ss += __shfl_xor(ss, 1); ss += __shfl_xor(ss, 2); ss += __shfl_xor(ss, 4);
    rk += __shfl_xor(rk, 1); rk += __shfl_xor(rk, 2); rk += __shfl_xor(rk, 4);
    if ((lane & 7) == 0) { kinv[(size_t)tok * 8 + (lane >> 3)] = 1.f / fmaxf(sqrtf(ss), 1e-12f); rkdot[(size_t)tok * 8 + (lane >> 3)] = rk; }
    if (lane < 48) {
      float o[8];
      conv_z3(o, zx, cwx);
      if (lane < 16) {
#pragma unroll
        for (int e = 0; e < 8; ++e) o[e] = 1.f - 2.f / (1.f + __expf(2.f * o[e]));
        *(u32x4*)(TW + (size_t)tok * 128 + 8 * lane) = pack8(o);
      } else if (lane < 32) {
        *(u32x4*)(ZA + (size_t)tok * 128 + 8 * (lane - 16)) = pack8(o);
      } else {
#pragma unroll
        for (int e = 0; e < 8; ++e) o[e] = sigm(o[e]);
        *(u32x4*)(SG + (size_t)tok * 128 + 8 * (lane - 32)) = pack8(o);
      }
    }
    float sq = 0.f, skv = 0.f;
    if (lane < 48) {
#pragma unroll
      for (int e = 0; e < 4; ++e) { const float a = bflo(zqv[e]), b2 = bfhi(zqv[e]); sq += a * a + b2 * b2; } }
    if (lane < 32) {
#pragma unroll
      for (int e = 0; e < 4; ++e) { const float a = bflo(zkvv[e]), b2 = bfhi(zkvv[e]); skv += a * a + b2 * b2; } }
#pragma unroll
    for (int m = 1; m < 64; m <<= 1) { sq += __shfl_xor(sq, m); skv += __shfl_xor(skv, m); }
    if (lane == 0) { rsq[tok] = rsqrtf(sq * (1.f / 384.f) + 1e-6f); rskv[tok] = rsqrtf(skv * (1.f / 256.f) + 1e-6f); }
    if (lane < 16) {
      const float ang = (float)posv * invf;
      float si, co; sincosf(ang, &si, &co);
      cs[(size_t)tok * 32 + lane] = co; cs[(size_t)tok * 32 + 16 + lane] = si;
      const float x1 = bf2f(kr1), x2 = bf2f(kr2);
      kpe[(size_t)tok * 32 + lane] = f2bf(x1 * co - x2 * si);
      kpe[(size_t)tok * 32 + 16 + lane] = f2bf(x1 * si + x2 * co);
    }
  }
}

DI void scan_item(const Params& p, int pair, char* smem0) {
  char* ws = launder(p.ws);
  const int tid = tidx(), lane = tid & 63, w = (tid >> 6) & 3, half = __builtin_amdgcn_readfirstlane(tid >> 8);
  const int item = pair * 2 + half;
  const int dir = item & 1, h = (item >> 1) & 7, b = item >> 4;
  char* smem = smem0 + half * 53248;
  float* opbuf = (float*)smem;
  float* ybuf = (float*)(smem + 49152) + w * 256;
  const bf16_t *R = (const bf16_t*)(ws + OFF_R), *K = (const bf16_t*)(ws + OFF_K), *V = (const bf16_t*)(ws + OFF_V), *TW = (const bf16_t*)(ws + OFF_TW), *ZA = (const bf16_t*)(ws + OFF_ZA);
  const float* kinv = (const float*)(ws + OFF_KINV);
  bf16_t* Y = (bf16_t*)(ws + (dir ? OFF_YB : OFF_YF));
  const int n = w * 16 + (lane & 15), gc = h * 64 + n;
  bf16x8 bw[2], ba[2];
#pragma unroll
  for (int ks = 0; ks < 2; ++ks) {
    bw[ks] = *(const bf16x8*)((const bf16_t*)(ws + OFF_WW2) + ((size_t)(dir * 512 + gc)) * 64 + ks * 32 + (lane >> 4) * 8);
    ba[ks] = *(const bf16x8*)((const bf16_t*)(ws + OFF_WA2) + ((size_t)(dir * 512 + gc)) * 64 + ks * 32 + (lane >> 4) * 8);
  }
  const float w0v = p.rw_w0[dir * 512 + gc], a0v = p.rw_a0[dir * 512 + gc], kkv = p.rw_k_k[gc], kav = p.rw_k_a[gc];
  const int tokb = b * SEQ;
  auto tok_of = [&](int ci, int tau) -> int { const int t = ci * 16 + tau; return tokb + (dir ? (SEQ - 1 - t) : t); };
  bf16x8 ta[2], za[2]; unsigned short kr[4], rr[4], vr[4]; float kiv[4];
  auto prep_load = [&](int ci) {
    const int tk = tok_of(ci, lane & 15);
#pragma unroll
    for (int ks = 0; ks < 2; ++ks) {
      ta[ks] = *(const bf16x8*)(TW + (size_t)tk * 128 + dir * 64 + ks * 32 + (lane >> 4) * 8);
      za[ks] = *(const bf16x8*)(ZA + (size_t)tk * 128 + dir * 64 + ks * 32 + (lane >> 4) * 8);
    }
#pragma unroll
    for (int j = 0; j < 4; ++j) {
      const int t2 = tok_of(ci, (lane >> 4) * 4 + j);
      kr[j] = K[(size_t)t2 * 512 + gc]; rr[j] = R[(size_t)t2 * 512 + gc]; vr[j] = V[(size_t)t2 * 512 + gc]; kiv[j] = kinv[(size_t)t2 * 8 + h];
    }
  };
  auto prep_finish = [&](int stage) {
    f32x4 aw = (f32x4){0.f, 0.f, 0.f, 0.f}, aa = aw;
    aw = __builtin_amdgcn_mfma_f32_16x16x32_bf16(ta[0], bw[0], aw, 0, 0, 0); aw = __builtin_amdgcn_mfma_f32_16x16x32_bf16(ta[1], bw[1], aw, 0, 0, 0);
    aa = __builtin_amdgcn_mfma_f32_16x16x32_bf16(za[0], ba[0], aa, 0, 0, 0); aa = __builtin_amdgcn_mfma_f32_16x16x32_bf16(za[1], ba[1], aa, 0, 0, 0);
#pragma unroll
    for (int j = 0; j < 4; ++j) {
      const int tau = (lane >> 4) * 4 + j;
      const float kval = bf2f(kr[j]), rval = bf2f(rr[j]), vval = bf2f(vr[j]);
      const float u = w0v + aw[j];
      const float z = -u, sp = fmaxf(z, 0.f) + __logf(1.f + __expf(-fabsf(z)));
      const float dec = __expf(-__expf(-sp - 0.5f));
      const float alr = 1.f / (1.f + __expf(-(a0v + aa[j])));
      const float kkn = kval * kkv * kiv[j];
      float* ob = opbuf + stage * 6144 + tau * 384 + n;
      ob[0] = -kkn; ob[64] = dec; ob[128] = kkn * alr; ob[192] = kval * (1.f + (alr - 1.f) * kav); ob[256] = rval; ob[320] = vval;
    }
  };
  f32x4 paw = (f32x4){0.f, 0.f, 0.f, 0.f}, paa = paw;
  auto prep_mfma = [&]() {
    f32x4 z4 = (f32x4){0.f, 0.f, 0.f, 0.f};
    paw = __builtin_amdgcn_mfma_f32_16x16x32_bf16(ta[0], bw[0], z4, 0, 0, 0); paw = __builtin_amdgcn_mfma_f32_16x16x32_bf16(ta[1], bw[1], paw, 0, 0, 0);
    paa = __builtin_amdgcn_mfma_f32_16x16x32_bf16(za[0], ba[0], z4, 0, 0, 0); paa = __builtin_amdgcn_mfma_f32_16x16x32_bf16(za[1], ba[1], paa, 0, 0, 0);
  };
  auto prep_elem = [&](int j, int stage) {
    const int tau = (lane >> 4) * 4 + j;
    const float kval = bf2f(kr[j]), rval = bf2f(rr[j]), vval = bf2f(vr[j]);
    const float u = w0v + paw[j];
    const float z = -u, sp = fmaxf(z, 0.f) + __logf(1.f + __expf(-fabsf(z)));
    const float dec = __expf(-__expf(-sp - 0.5f));
    const float alr = 1.f / (1.f + __expf(-(a0v + paa[j])));
    const float kkn = kval * kkv * kiv[j];
    float* ob = opbuf + stage * 6144 + tau * 384 + n;
    ob[0] = -kkn; ob[64] = dec; ob[128] = kkn * alr; ob[192] = kval * (1.f + (alr - 1.f) * kav); ob[256] = rval; ob[320] = vval;
  };
  float S0[8], S1[8];
#pragma unroll
  for (int c = 0; c < 8; ++c) { S0[c] = 0.f; S1[c] = 0.f; }
  const int cq = lane & 7, rp = lane >> 3, irow = w * 16 + 2 * rp;
  struct Ops { f32x4 a0, a1, w0, w1, b0, b1, k0, k1, r0, r1; f32x2 v; };
  auto load_ops = [&](Ops& o, const float* obase, int tau) {
    const float* ob = obase + tau * 384 + cq * 8;
    o.a0 = *(const f32x4*)(ob); o.a1 = *(const f32x4*)(ob + 4);
    o.v = *(const f32x2*)(obase + tau * 384 + 320 + irow);
    o.w0 = *(const f32x4*)(ob + 64); o.w1 = *(const f32x4*)(ob + 68);
    o.b0 = *(const f32x4*)(ob + 128); o.b1 = *(const f32x4*)(ob + 132);
    o.k0 = *(const f32x4*)(ob + 192); o.k1 = *(const f32x4*)(ob + 196);
    o.r0 = *(const f32x4*)(ob + 256); o.r1 = *(const f32x4*)(ob + 260);
  };
  auto red8 = [&](float x) -> float { x += dppf<0xB1>(x); x += dppf<0x4E>(x); x += dppf<0x141>(x); return x; };
  auto step = [&](const Ops& o, int tau) {
    float A[8], W[8], Bv[8], Kv[8], Rv[8];
#pragma unroll
    for (int e = 0; e < 4; ++e) { A[e] = o.a0[e]; A[4 + e] = o.a1[e]; W[e] = o.w0[e]; W[4 + e] = o.w1[e]; Bv[e] = o.b0[e]; Bv[4 + e] = o.b1[e];
      Kv[e] = o.k0[e]; Kv[4 + e] = o.k1[e]; Rv[e] = o.r0[e]; Rv[4 + e] = o.r1[e]; }
    float sa0 = mul_s(S0[0], A[0]), sa1 = mul_s(S1[0], A[0]);
#pragma unroll
    for (int c = 1; c < 8; ++c) { sa0 = fma_s(S0[c], A[c], sa0); sa1 = fma_s(S1[c], A[c], sa1); }
    float t0[8], t1[8];
#pragma unroll
    for (int c = 0; c < 8; ++c) { t0[c] = mul_s(o.v[0], Kv[c]); t1[c] = mul_s(o.v[1], Kv[c]); }
    sa0 = red8(sa0); sa1 = red8(sa1);
    float y0 = 0.f, y1 = 0.f;
#pragma unroll
    for (int c = 0; c < 8; ++c) {
      S0[c] = fma_s(S0[c], W[c], fma_s(sa0, Bv[c], t0[c]));
      S1[c] = fma_s(S1[c], W[c], fma_s(sa1, Bv[c], t1[c]));
      y0 = fma_s(S0[c], Rv[c], y0); y1 = fma_s(S1[c], Rv[c], y1);
    }
    y0 = red8(y0); y1 = red8(y1);
    if (cq == 0) *(f32x2*)(ybuf + tau * 16 + 2 * rp) = (f32x2){y0, y1};
  };
  prep_load(0); prep_finish(0); prep_load(1);
  __syncthreads();
  for (int ci = 0; ci < SEQ / 16; ++ci) {
    const bool more = ci + 1 < SEQ / 16;
    const float* obase = opbuf + (ci & 1) * 6144;
    Ops oa, ob2;
    load_ops(oa, obase, 0);
#pragma unroll
    for (int tau = 0; tau < 16; tau += 2) {
      load_ops(ob2, obase, tau + 1);
      __builtin_amdgcn_sched_barrier(0);
      step(oa, tau);
      if (more) { if (tau == 0) prep_mfma(); else if ((tau & 3) == 2) prep_elem((tau - 2) >> 2, (ci + 1) & 1); }
      __builtin_amdgcn_sched_barrier(0);
      if (tau + 2 < 16) load_ops(oa, obase, tau + 2);
      __builtin_amdgcn_sched_barrier(0);
      step(ob2, tau + 1);
      __builtin_amdgcn_sched_barrier(0);
    }
    {
      const int tau = lane >> 2, r4 = (lane & 3) * 4;
      const f32x4 yv = *(const f32x4*)(ybuf + tau * 16 + r4);
      *(u32x2*)(Y + (size_t)tok_of(ci, tau) * 512 + h * 64 + w * 16 + r4) = (u32x2){pk2(yv[0], yv[1]), pk2(yv[2], yv[3])};
    }
    if (ci + 2 < SEQ / 16) prep_load(ci + 2);
    __syncthreads();
  }
}

constexpr int KROW = 208, VROW = 136, KT_BYTES = 64 * KROW, VT_BYTES = 64 * VROW, ATT_STAGE = KT_BYTES + VT_BYTES;
DI int crow16(int i, int hh) { return (i & 3) + 8 * (i >> 2) + 4 * hh; }
DI void attn_item(const Params& p, int item, char* smem) {
  char* ws = launder(p.ws);
  const int qb = item & 7, bh = item >> 3, b = bh >> 3, h = bh & 7;
  const int tid = tidx(), lane = tid & 63, w = tid >> 6, l31 = lane & 31, hh = lane >> 5;
  const bf16_t* Q = (const bf16_t*)(ws + OFF_Q) + ((size_t)bh * SEQ + qb * 256 + w * 32 + l31) * 96;
  const bf16_t* Kn = (const bf16_t*)(ws + OFF_KN) + (size_t)bh * SEQ * 64;
  const bf16_t* Kpe = (const bf16_t*)(ws + OFF_KPE) + (size_t)b * SEQ * 32;
  const bf16_t* VT = (const bf16_t*)(ws + OFF_VT) + (size_t)bh * 64 * SEQ;
  bf16x8 qf[6];
#pragma unroll
  for (int ks = 0; ks < 6; ++ks) qf[ks] = *(const bf16x8*)(Q + ks * 16 + hh * 8);
  u32x4 kreg[2], vreg[1];
  auto gload = [&](int kt) {
    const int k0 = kt * 64;
#pragma unroll
    for (int i = 0; i < 2; ++i) { const int cid = tid + 512 * i, key = cid / 12, c = cid % 12;
      if (cid < 768) kreg[i] = (c < 8) ? *(const u32x4*)(Kn + (size_t)(k0 + key) * 64 + c * 8) : *(const u32x4*)(Kpe + (size_t)(k0 + key) * 32 + (c - 8) * 8); }
#pragma unroll
    for (int i = 0; i < 1; ++i) { const int cid = tid, dv = cid >> 3, c = cid & 7; vreg[i] = *(const u32x4*)(VT + (size_t)dv * SEQ + k0 + c * 8); }
  };
  auto lstore = [&](int stage) {
    char* st = smem + stage * ATT_STAGE;
#pragma unroll
    for (int i = 0; i < 2; ++i) { const int cid = tid + 512 * i, key = cid / 12, c = cid % 12; if (cid < 768) *(u32x4*)(st + key * KROW + c * 16) = kreg[i]; }
#pragma unroll
    for (int i = 0; i < 1; ++i) { const int cid = tid, dv = cid >> 3, c = cid & 7; char* d = st + KT_BYTES + dv * VROW + c * 16;
      *(u32x2*)d = (u32x2){vreg[i][0], vreg[i][1]}; *(u32x2*)(d + 8) = (u32x2){vreg[i][2], vreg[i][3]}; }
  };
  f32x16 o0, o1;
#pragma unroll
  for (int i = 0; i < 16; ++i) { o0[i] = 0.f; o1[i] = 0.f; }
  float mrun = 0.f, lsum = 0.f;
  f32x16 negm;
#pragma unroll
  for (int i = 0; i < 16; ++i) negm[i] = 0.f;
  gload(0); lstore(0);
  __syncthreads();
  for (int kt = 0; kt < SEQ / 64; ++kt) {
    const bool more = kt + 1 < SEQ / 64;
    if (more) gload(kt + 1);
    __builtin_amdgcn_sched_barrier(0);
    const char* st = smem + (kt & 1) * ATT_STAGE;
    f32x16 s0 = negm, s1 = negm;
#pragma unroll
    for (int ks = 0; ks < 6; ++ks) {
      const bf16x8 k0f = *(const bf16x8*)(st + l31 * KROW + ks * 32 + hh * 16);
      const bf16x8 k1f = *(const bf16x8*)(st + (32 + l31) * KROW + ks * 32 + hh * 16);
      s0 = __builtin_amdgcn_mfma_f32_32x32x16_bf16(k0f, qf[ks], s0, 0, 0, 0);
      s1 = __builtin_amdgcn_mfma_f32_32x32x16_bf16(k1f, qf[ks], s1, 0, 0, 0);
    }
    float mx = fmaxf(s0[0], s1[0]);
#pragma unroll
    for (int i = 1; i < 16; ++i) mx = fmaxf(mx, fmaxf(s0[i], s1[i]));
    mx = fmaxf(mx, __shfl_xor(mx, 32));
    if (kt == 0 || __any(mx > 8.f)) {
      const float alpha = __builtin_amdgcn_exp2f(-mx);
      mrun += mx; lsum *= alpha;
#pragma unroll
      for (int i = 0; i < 16; ++i) { s0[i] -= mx; s1[i] -= mx; o0[i] *= alpha; o1[i] *= alpha; negm[i] = -mrun; }
    }
    float ps = 0.f;
#pragma unroll
    for (int i = 0; i < 16; ++i) { s0[i] = __builtin_amdgcn_exp2f(s0[i]); s1[i] = __builtin_amdgcn_exp2f(s1[i]); ps += s0[i] + s1[i]; }
    lsum += ps;
    const char* vt = st + KT_BYTES;
#pragma unroll
    for (int s4 = 0; s4 < 4; ++s4) {
      const int ss = s4 & 1;
      u32x4 pw;
      if (s4 < 2) pw = (u32x4){pk2(s0[8 * ss], s0[8 * ss + 1]), pk2(s0[8 * ss + 2], s0[8 * ss + 3]), pk2(s0[8 * ss + 4], s0[8 * ss + 5]), pk2(s0[8 * ss + 6], s0[8 * ss + 7])};
      else pw = (u32x4){pk2(s1[8 * ss], s1[8 * ss + 1]), pk2(s1[8 * ss + 2], s1[8 * ss + 3]), pk2(s1[8 * ss + 4], s1[8 * ss + 5]), pk2(s1[8 * ss + 6], s1[8 * ss + 7])};
      const bf16x8 pf = __builtin_bit_cast(bf16x8, pw);
      const int koff = (s4 * 16 + 4 * hh) * 2;
      const u32x2 a0 = *(const u32x2*)(vt + l31 * VROW + koff), a1 = *(const u32x2*)(vt + l31 * VROW + koff + 16);
      const u32x2 b0 = *(const u32x2*)(vt + (32 + l31) * VROW + koff), b1 = *(const u32x2*)(vt + (32 + l31) * VROW + koff + 16);
      const bf16x8 v0f = __builtin_bit_cast(bf16x8, ((u32x4){a0[0], a0[1], a1[0], a1[1]}));
      const bf16x8 v1f = __builtin_bit_cast(bf16x8, ((u32x4){b0[0], b0[1], b1[0], b1[1]}));
      o0 = __builtin_amdgcn_mfma_f32_32x32x16_bf16(v0f, pf, o0, 0, 0, 0);
      o1 = __builtin_amdgcn_mfma_f32_32x32x16_bf16(v1f, pf, o1, 0, 0, 0);
    }
    __builtin_amdgcn_sched_barrier(0);
    if (more) lstore((kt + 1) & 1);
    __syncthreads();
  }
  lsum += __shfl_xor(lsum, 32);
  const float inv = 1.f / lsum;
  bf16_t* O = (bf16_t*)(ws + OFF_YMLA) + ((size_t)b * SEQ + qb * 256 + w * 32 + l31) * 512 + h * 64;
#pragma unroll
  for (int g = 0; g < 4; ++g) {
    const int dv = 8 * g + 4 * hh;
    *(u32x2*)(O + dv) = (u32x2){pk2(o0[4 * g] * inv, o0[4 * g + 1] * inv), pk2(o0[4 * g + 2] * inv, o0[4 * g + 3] * inv)};
    *(u32x2*)(O + 32 + dv) = (u32x2){pk2(o1[4 * g] * inv, o1[4 * g + 1] * inv), pk2(o1[4 * g + 2] * inv, o1[4 * g + 3] * inv)};
  }
}

DI void phase5(const Params& p, char* smem) {
  char* ws = launder(p.ws);
  bf16_t* mixed = (bf16_t*)(ws + OFF_MIXED);
  const int lane = tidx() & 63, wid = tidx() >> 6;
  const int nT = (NTOK / 256) * 4;
  for (int t2 = 2 * blockIdx.x; t2 < 2 * nT; t2 += 2 * gridDim.x) {
    for (int pass = 0; pass < 2; ++pass) {
      const int t = t2 >> 1;
      const int m0 = (t >> 2) * 256, n0 = (t & 3) * 256;
      const int rb = m0 + (wid >> 2) * 128, cb = n0 + (wid & 3) * 64;
      const bf16_t* Aop = (const bf16_t*)(ws + (pass ? OFF_YMLA : OFF_YRW));
      const bf16_t* Wop = (const bf16_t*)(ws + (pass ? OFF_WBR2 : OFF_WBR1));
      const bf16_t* gate = (const bf16_t*)(ws + (pass ? OFF_GB : OFF_GA));
      f32x4 acc[MI][4];
      zero_acc(acc);
      gemm_tile_acc(acc, Aop, 512, Wop, 512, m0, n0, 512, smem);
#pragma unroll
      for (int mi = 0; mi < MI; ++mi) {
        int row_ = rb + mi * 16 + (lane & 15); asm volatile("" : "+v"(row_) :: "memory");
#pragma unroll
        for (int ni = 0; ni < 4; ++ni) {
          const size_t o = (size_t)row_ * DM + cb + ni * 16 + (lane >> 4) * 4;
          const u32x2 g = *(const u32x2*)(gate + o);
          f32x4 v = acc[mi][ni] * (f32x4){bflo(g[0]), bfhi(g[0]), bflo(g[1]), bfhi(g[1])};
          if (pass) { const u32x2 mm = *(const u32x2*)(mixed + o); v += (f32x4){bflo(mm[0]), bfhi(mm[0]), bflo(mm[1]), bfhi(mm[1])}; }
          *(u32x2*)(mixed + o) = (u32x2){pk2(v[0], v[1]), pk2(v[2], v[3])};
        }
      }
    }
  }
}

template <bool WITH_H>
DI void ln_phase(const float* in, float* outp, const float* __restrict__ g, const float* __restrict__ be, const float* mod, bf16_t* hout) {
  const int lane = tidx() & 63, wid = tidx() >> 6;
  constexpr int R = 4;
  for (int rb = (blockIdx.x * 8 + wid) * R; rb < NTOK; rb += gridDim.x * 8 * R) {
    f32x4 v[R][4]; float s[R], q[R];
#pragma unroll
    for (int r = 0; r < R; ++r)
#pragma unroll
      for (int i = 0; i < 4; ++i) v[r][i] = *(const f32x4*)(in + (size_t)(rb + r) * DM + i * 256 + lane * 4);
#pragma unroll
    for (int r = 0; r < R; ++r) { s[r] = 0.f;
#pragma unroll
      for (int i = 0; i < 4; ++i) s[r] += (v[r][i][0] + v[r][i][1]) + (v[r][i][2] + v[r][i][3]); }
#pragma unroll
    for (int m = 1; m < 64; m <<= 1)
#pragma unroll
      for (int r = 0; r < R; ++r) s[r] += __shfl_xor(s[r], m);
#pragma unroll
    for (int r = 0; r < R; ++r) { const float mean = s[r] * (1.f / 1024.f); s[r] = mean; q[r] = 0.f;
#pragma unroll
      for (int i = 0; i < 4; ++i) { const f32x4 d = v[r][i] - mean; q[r] += (d[0] * d[0] + d[1] * d[1]) + (d[2] * d[2] + d[3] * d[3]); } }
#pragma unroll
    for (int m = 1; m < 64; m <<= 1)
#pragma unroll
      for (int r = 0; r < R; ++r) q[r] += __shfl_xor(q[r], m);
    const int b = rb / SEQ;
#pragma unroll
    for (int r = 0; r < R; ++r) {
      const int row = rb + r;
      const float mean = s[r], rstd = rsqrtf(q[r] * (1.f / 1024.f) + 1e-5f);
      if (WITH_H && lane == 0) *(f32x2*)(outp + (size_t)row * 2) = (f32x2){mean, rstd};
#pragma unroll
      for (int i = 0; i < 4; ++i) {
        const int col = i * 256 + lane * 4;
        const f32x4 o = (v[r][i] - mean) * rstd * *(const f32x4*)(g + col) + *(const f32x4*)(be + col);
        if (!WITH_H) *(f32x4*)(outp + (size_t)row * DM + col) = o;
        if (WITH_H) {
          const f32x4 sh = *(const f32x4*)(mod + b * 6144 + 3072 + col), sc = *(const f32x4*)(mod + b * 6144 + 4096 + col) + 1.f;
          const f32x4 hv = o * sc + sh;
          *(u32x2*)(hout + (size_t)row * DM + col) = (u32x2){pk2(hv[0], hv[1]), pk2(hv[2], hv[3])};
        }
      }
    }
  }
}

DI void ln1_phase(const bf16_t* in, float* stats, const float* __restrict__ g, const float* __restrict__ be, const float* mod, bf16_t* hout) {
  const int lane = tidx() & 63, wid = tidx() >> 6;
  constexpr int R = 4;
  for (int rb = (blockIdx.x * 8 + wid) * R; rb < NTOK; rb += gridDim.x * 8 * R) {
    u32x4 raw[R][2]; f32x4 v[R][4]; float s[R], q[R];
#pragma unroll
    for (int r = 0; r < R; ++r)
#pragma unroll
      for (int i = 0; i < 2; ++i) raw[r][i] = *(const u32x4*)(in + (size_t)(rb + r) * DM + i * 512 + lane * 8);
#pragma unroll
    for (int r = 0; r < R; ++r) { s[r] = 0.f;
#pragma unroll
      for (int i = 0; i < 2; ++i) {
        v[r][2 * i] = (f32x4){bflo(raw[r][i][0]), bfhi(raw[r][i][0]), bflo(raw[r][i][1]), bfhi(raw[r][i][1])};
        v[r][2 * i + 1] = (f32x4){bflo(raw[r][i][2]), bfhi(raw[r][i][2]), bflo(raw[r][i][3]), bfhi(raw[r][i][3])};
        s[r] += ((v[r][2 * i][0] + v[r][2 * i][1]) + (v[r][2 * i][2] + v[r][2 * i][3])) + ((v[r][2 * i + 1][0] + v[r][2 * i + 1][1]) + (v[r][2 * i + 1][2] + v[r][2 * i + 1][3]));
      } }
#pragma unroll
    for (int m = 1; m < 64; m <<= 1)
#pragma unroll
      for (int r = 0; r < R; ++r) s[r] += __shfl_xor(s[r], m);
#pragma unroll
    for (int r = 0; r < R; ++r) { const float mean = s[r] * (1.f / 1024.f); s[r] = mean; q[r] = 0.f;
#pragma unroll
      for (int i = 0; i < 4; ++i) { const f32x4 d = v[r][i] - mean; q[r] += (d[0] * d[0] + d[1] * d[1]) + (d[2] * d[2] + d[3] * d[3]); } }
#pragma unroll
    for (int m = 1; m < 64; m <<= 1)
#pragma unroll
      for (int r = 0; r < R; ++r) q[r] += __shfl_xor(q[r], m);
    const int b = rb / SEQ;
#pragma unroll
    for (int r = 0; r < R; ++r) {
      const int row = rb + r;
      const float mean = s[r], rstd = rsqrtf(q[r] * (1.f / 1024.f) + 1e-5f);
      if (lane == 0) *(f32x2*)(stats + (size_t)row * 2) = (f32x2){mean, rstd};
#pragma unroll
      for (int i = 0; i < 2; ++i) {
        const int col = i * 512 + lane * 8;
        f32x4 hv[2];
#pragma unroll
        for (int hh = 0; hh < 2; ++hh) {
          const int c = col + 4 * hh;
          const f32x4 o = (v[r][2 * i + hh] - mean) * rstd * *(const f32x4*)(g + c) + *(const f32x4*)(be + c);
          const f32x4 sh = *(const f32x4*)(mod + b * 6144 + 3072 + c), sc = *(const f32x4*)(mod + b * 6144 + 4096 + c) + 1.f;
          hv[hh] = o * sc + sh;
        }
        *(u32x4*)(hout + (size_t)row * DM + col) = (u32x4){pk2(hv[0][0], hv[0][1]), pk2(hv[0][2], hv[0][3]), pk2(hv[1][0], hv[1][1]), pk2(hv[1][2], hv[1][3])};
      }
    }
  }
}

DI void gsync(unsigned* bar, unsigned& target) {
  asm volatile("s_waitcnt vmcnt(0) lgkmcnt(0)" ::: "memory");
  __syncthreads();
  target += gridDim.x;
  if (tidx() == 0) {
    __builtin_amdgcn_fence(__ATOMIC_RELEASE, "agent");
    asm volatile("s_waitcnt vmcnt(0)" ::: "memory");
    __hip_atomic_fetch_add(bar, 1u, __ATOMIC_RELAXED, __HIP_MEMORY_SCOPE_AGENT);
    while (__hip_atomic_load(bar, __ATOMIC_RELAXED, __HIP_MEMORY_SCOPE_AGENT) < target) __builtin_amdgcn_s_sleep(4);
    __builtin_amdgcn_fence(__ATOMIC_ACQUIRE, "agent");
    asm volatile("s_waitcnt vmcnt(0)" ::: "memory");
  }
  __syncthreads();
}

__global__ void __launch_bounds__(512, 2) fwd_mega(Params p) {
  __shared__ __attribute__((aligned(16))) char smem[131072];
  cg::grid_group grid = cg::this_grid();
  char* ws = launder(p.ws);
  unsigned* bar = (unsigned*)p.ws; unsigned target = 0;
  phase0a(p, smem);
  grid.sync();
  phase0b(p, smem);
  gsync(bar, target);
  ws = launder(ws);
  { InElem e{ws}; pg8_gemm8(smem, (const bf16_t*)(ws + OFF_HBF), (const bf16_t*)(ws + OFF_WIN), NTOK, DIN_PAD, DM, e); }
  gsync(bar, target);
  phase2(p);
  gsync(bar, target);
  ws = launder(ws);
  { EpiQ e{ws}; gemm_phase((const bf16_t*)(ws + OFF_ZQ), 384, (const bf16_t*)(ws + OFF_WUQ), 384, NTOK, 768, 384, smem, e); }
  ws = launder(ws);
  { EpiKV e{ws}; gemm_phase((const bf16_t*)(ws + OFF_ZKV), 256, (const bf16_t*)(ws + OFF_WUKV), 256, NTOK, 1024, 256, smem, e); }
  gsync(bar, target);
  for (int it = blockIdx.x; it < 256; it += gridDim.x) scan_item(p, it, smem);
  for (int it = blockIdx.x; it < 2048; it += gridDim.x) attn_item(p, it, smem);
  gsync(bar, target);
  ws = launder(ws);
  { EpiG8 e{ws, p.rw_lnx_g, p.rw_lnx_b}; gemm_phase<EpiG8, true>((const bf16_t*)(ws + OFF_SG), 128, (const bf16_t*)(ws + OFF_WG2), 128, NTOK, 512, 128, smem, e); }
  gsync(bar, target);
  ws = launder(ws);
  { MixElem e{(const bf16_t*)(ws + OFF_GA), (bf16_t*)(ws + OFF_MIXED), 0}; pg8_gemm8(smem, (const bf16_t*)(ws + OFF_YRW), (const bf16_t*)(ws + OFF_WBR1), NTOK, DM, 512, e); }
  ws = launder(ws);
  { MixElem e{(const bf16_t*)(ws + OFF_GB), (bf16_t*)(ws + OFF_MIXED), 1}; pg8_gemm8(smem, (const bf16_t*)(ws + OFF_YMLA), (const bf16_t*)(ws + OFF_WBR2), NTOK, DM, 512, e); }
  gsync(bar, target);
  ws = launder(ws);
  { T1bElem e{p.x, (const float*)(ws + OFF_MOD) + 2048, (bf16_t*)(ws + OFF_T1)}; pg8_gemm8(smem, (const bf16_t*)(ws + OFF_MIXED), (const bf16_t*)(ws + OFF_WOUT), NTOK, DM, DM, e); }
  gsync(bar, target);
  ws = launder(ws);
  ln1_phase((const bf16_t*)(ws + OFF_T1), (float*)(ws + OFF_RSQ), p.ln1_g, p.ln1_b, (const float*)(ws + OFF_MOD), (bf16_t*)(ws + OFF_HBF));
  gsync(bar, target);
  ws = launder(ws);
  { Relu2Elem e{(bf16_t*)(ws + OFF_HID)}; pg8_gemm8(smem, (const bf16_t*)(ws + OFF_HBF), (const bf16_t*)(ws + OFF_WFF1), NTOK, DFF, DM, e); }
  gsync(bar, target);
  ws = launder(ws);
  { Res2bElem e{(const bf16_t*)(ws + OFF_T1), (const float*)(ws + OFF_RSQ), p.ln1_g, p.ln1_b, (const float*)(ws + OFF_MOD) + 5120, p.out}; pg8_gemm8(smem, (const bf16_t*)(ws + OFF_HID), (const bf16_t*)(ws + OFF_WFF2), NTOK, DM, DFF, e); }
  gsync(bar, target);
  ln_phase<false>(p.out, p.out, p.ln2_g, p.ln2_b, nullptr, nullptr);
}

extern "C" void kernel_launch(void* const* d_in, const int* in_sizes, int n_in, void* d_out, int out_size, void* d_ws, size_t ws_size, hipStream_t stream) {
  static int grid_blocks = 0;
  if (!grid_blocks) {
    int dev = 0, cus = 0, per_cu = 0;
    hipGetDevice(&dev);
    hipDeviceGetAttribute(&cus, hipDeviceAttributeMultiprocessorCount, dev);
    hipOccupancyMaxActiveBlocksPerMultiprocessor(&per_cu, fwd_mega, 512, 0);
    if (per_cu > 1) per_cu = 1;
    if (per_cu < 1) per_cu = 1;
    grid_blocks = cus * per_cu;
  }
  Params p{};
  p.x = (const float*)d_in[0]; p.c = (const float*)d_in[1]; p.pos = (const int*)d_in[2];
  p.w_ada = (const float*)d_in[3]; p.b_ada = (const float*)d_in[4]; p.w_in = (const float*)d_in[5]; p.rw_conv = (const float*)d_in[6];
  p.rw_w0 = (const float*)d_in[7]; p.rw_w2 = (const float*)d_in[8]; p.rw_a0 = (const float*)d_in[9]; p.rw_a2 = (const float*)d_in[10];
  p.rw_k_k = (const float*)d_in[11]; p.rw_k_a = (const float*)d_in[12]; p.rw_r_k = (const float*)d_in[13]; p.rw_g2 = (const float*)d_in[14];
  p.rw_lnx_g = (const float*)d_in[15]; p.rw_lnx_b = (const float*)d_in[16]; p.q_norm_g = (const float*)d_in[17]; p.kv_norm_g = (const float*)d_in[18];
  p.w_uq = (const float*)d_in[19]; p.w_ukv = (const float*)d_in[20]; p.w_br_rwkv = (const float*)d_in[21]; p.w_br_mla = (const float*)d_in[22];
  p.w_out = (const float*)d_in[23]; p.ln1_g = (const float*)d_in[24]; p.ln1_b = (const float*)d_in[25]; p.w_ff1 = (const float*)d_in[26];
  p.w_ff2 = (const float*)d_in[27]; p.ln2_g = (const float*)d_in[28]; p.ln2_b = (const float*)d_in[29];
  p.out = (float*)d_out; p.ws = (char*)d_ws;
  hipMemsetAsync(d_ws, 0, 256, stream);
  void* args[] = {&p};
  hipError_t e = hipLaunchCooperativeKernel((void*)fwd_mega, dim3(grid_blocks), dim3(512), args, 0, stream);
  if (e != hipSuccess) fprintf(stderr, "cooperative launch failed: %s (grid %d)\n", hipGetErrorString(e), grid_blocks);
}
```

```cpp
#include <hip/hip_runtime.h>
#include <hip/hip_cooperative_groups.h>
#include <stdint.h>
#include <stdio.h>
namespace cg = cooperative_groups;

#define DI __device__ __forceinline__
typedef unsigned short bf16_t;
typedef short bf16x8 __attribute__((ext_vector_type(8)));
typedef float f32x2 __attribute__((ext_vector_type(2)));
typedef float f32x4 __attribute__((ext_vector_type(4)));
typedef float f32x16 __attribute__((ext_vector_type(16)));
typedef unsigned u32x2 __attribute__((ext_vector_type(2)));
typedef unsigned u32x4 __attribute__((ext_vector_type(4)));
typedef __bf16 bf16x2_t __attribute__((ext_vector_type(2)));

constexpr int NB = 32, SEQ = 2048, DM = 1024, NTOK = NB * SEQ;
constexpr int DIN = 4640, DIN_PAD = 4864, DFF = 4096;
constexpr int NTHR = 512;
constexpr float DN_ALPHA = 1.189207115002721f;
constexpr size_t MiB = 1u << 20;
constexpr size_t OFF_MOD = 1 * MiB, OFF_PART = 512 * MiB, OFF_WIN = 8 * MiB, OFF_WFF1 = 18 * MiB, OFF_WFF2 = 26 * MiB, OFF_WOUT = 34 * MiB,
                 OFF_WBR1 = 36 * MiB, OFF_WBR2 = 37 * MiB, OFF_WUQ = 38 * MiB, OFF_WUKV = 39 * MiB, OFF_WW2 = 40 * MiB, OFF_WA2 = 40 * MiB + 262144,
                 OFF_WG2 = 40 * MiB + 524288, OFF_RSQ = 41 * MiB, OFF_RSKV = 41 * MiB + 524288, OFF_KINV = 42 * MiB, OFF_RKDOT = 44 * MiB, OFF_CS = 46 * MiB;
constexpr size_t OFF_HBF = 56 * MiB, OFF_TW = 56 * MiB, OFF_ZA = 72 * MiB, OFF_SG = 88 * MiB, OFF_YF = 104 * MiB;
constexpr size_t OFF_ZRW = 184 * MiB, OFF_Q = 184 * MiB, OFF_KN = 280 * MiB, OFF_VT = 344 * MiB, OFF_MIXED = 184 * MiB, OFF_HID = 184 * MiB;
constexpr size_t OFF_ZQ = 424 * MiB, OFF_ZKV = 472 * MiB, OFF_ZKR = 504 * MiB, OFF_KPE = 508 * MiB, OFF_YB = 424 * MiB;
constexpr size_t OFF_GA = 512 * MiB, OFF_GB = 640 * MiB;
constexpr size_t OFF_R = 768 * MiB, OFF_K = 832 * MiB, OFF_V = 896 * MiB, OFF_YRW = 768 * MiB, OFF_YMLA = 960 * MiB, OFF_T1 = 768 * MiB;

struct Params {
  const float *x, *c; const int* pos;
  const float *w_ada, *b_ada, *w_in, *rw_conv, *rw_w0, *rw_w2, *rw_a0, *rw_a2, *rw_k_k, *rw_k_a, *rw_r_k, *rw_g2, *rw_lnx_g, *rw_lnx_b,
      *q_norm_g, *kv_norm_g, *w_uq, *w_ukv, *w_br_rwkv, *w_br_mla, *w_out, *ln1_g, *ln1_b, *w_ff1, *w_ff2, *ln2_g, *ln2_b;
  float* out; char* ws;
};

DI unsigned pk2(float lo, float hi) { f32x2 v = {lo, hi}; bf16x2_t b = __builtin_convertvector(v, bf16x2_t); return __builtin_bit_cast(unsigned, b); }
DI unsigned short f2bf(float f) { return (unsigned short)(pk2(f, 0.f) & 0xffffu); }
DI float bf2f(unsigned short b) { return __uint_as_float(((unsigned)b) << 16); }
DI float bflo(unsigned u) { return __uint_as_float(u << 16); }
DI float bfhi(unsigned u) { return __uint_as_float(u & 0xffff0000u); }
DI float sigm(float x) { return 1.f / (1.f + __expf(-x)); }
template <int CTRL> DI float dppf(float x) { return __int_as_float(__builtin_amdgcn_update_dpp(0, __float_as_int(x), CTRL, 0xf, 0xf, true)); }
DI int tidx() { int t = __builtin_amdgcn_workitem_id_x(); asm volatile("" : "+v"(t)); return t; }
DI char* launder(char* p) { asm volatile("" : "+s"(p)); return p; }
DI float fma_s(float a, float b, float c) { float d; asm("v_fma_f32 %0, %1, %2, %3" : "=v"(d) : "v"(a), "v"(b), "v"(c)); return d; }
DI float mul_s(float a, float b) { float d; asm("v_mul_f32 %0, %1, %2" : "=v"(d) : "v"(a), "v"(b)); return d; }
DI float quad_sum(float x) { x += dppf<0xB1>(x); x += dppf<0x4E>(x); return x; }

DI void mod_partial_item(const Params& p, int item, char* smem) {
  const int nt = item % 24, kc = item / 24, tid = tidx(), k0 = kc * 128;
  float* sc = (float*)smem;
  for (int i = 0; i < 8; ++i) { const int idx = tid + 512 * i, b = idx >> 7, kk = idx & 127; const float v = p.c[b * DM + k0 + kk]; sc[kk * 32 + b] = v / (1.f + __expf(-v)); }
  __syncthreads();
  float acc[32];
#pragma unroll
  for (int b = 0; b < 32; ++b) acc[b] = 0.f;
  const int n = nt * 256 + (tid & 255), kh = (tid >> 8) * 64;
#pragma unroll 8
  for (int kk = kh; kk < kh + 64; ++kk) {
    const float w = p.w_ada[(size_t)(k0 + kk) * 6144 + n];
    const f32x4* s4 = (const f32x4*)(sc + kk * 32);
#pragma unroll
    for (int q = 0; q < 8; ++q) { const f32x4 s = s4[q]; acc[4 * q] += w * s[0]; acc[4 * q + 1] += w * s[1]; acc[4 * q + 2] += w * s[2]; acc[4 * q + 3] += w * s[3]; }
  }
  float* part = (float*)(p.ws + OFF_PART) + (size_t)(kc * 2 + (tid >> 8)) * 32 * 6144;
#pragma unroll
  for (int b = 0; b < 32; ++b) part[b * 6144 + n] = acc[b];
  __syncthreads();
}

DI void transpose_tile(const float* __restrict__ src, int N, bf16_t* dst, int ldd, int kt, int nt, const float* __restrict__ rowscale, int Nvalid, char* smem) {
  float* tile = (float*)smem;
  const int tid = tidx(), k0 = kt * 64, n0 = nt * 64, nn = tid & 63;
#pragma unroll
  for (int i = 0; i < 8; ++i) {
    const int kk = i * 8 + (tid >> 6);
    float v = 0.f;
    if (n0 + nn < Nvalid) { v = src[(size_t)(k0 + kk) * N + n0 + nn]; if (rowscale) v *= rowscale[k0 + kk]; }
    tile[kk * 65 + nn] = v;
  }
  __syncthreads();
  const int n = tid >> 3, kc = (tid & 7) * 8;
  unsigned w[4];
#pragma unroll
  for (int j = 0; j < 4; ++j) w[j] = pk2(tile[(kc + 2 * j) * 65 + n], tile[(kc + 2 * j + 1) * 65 + n]);
  bf16_t* d = dst + (size_t)(n0 + n) * ldd + k0 + kc;
  *(u32x4*)d = (u32x4){w[0], w[1], w[2], w[3]};
  __syncthreads();
}

DI void conv_item(const float* __restrict__ src, int N, bf16_t* dst, int ldd, int nb, int kc, const float* __restrict__ rowscale, int Nvalid, int Npad) {
  const int n = nb * 512 + tidx(), k0 = kc * 8;
  if (n >= Npad) return;
  float v[8];
#pragma unroll
  for (int j = 0; j < 8; ++j) v[j] = (n < Nvalid) ? src[(size_t)(k0 + j) * N + n] : 0.f;
  if (rowscale) {
#pragma unroll
    for (int j = 0; j < 8; ++j) v[j] *= rowscale[k0 + j];
  }
  *(u32x4*)(dst + (size_t)n * ldd + k0) = (u32x4){pk2(v[0], v[1]), pk2(v[2], v[3]), pk2(v[4], v[5]), pk2(v[6], v[7])};
}
DI void phase0a(const Params& p, char* smem) {
  char* ws = launder(p.ws);
  constexpr int N_MOD = 192;
  constexpr int T_IN = 10 * 128, T_FF1 = 8 * 128, T_FF2 = 2 * 512, T_OUT = 2 * 128, T_BR = 2 * 64, T_UQ = 2 * 48, T_UKV = 2 * 32, T_L = 8, T_G2 = 16;
  constexpr int E0 = N_MOD, E1 = E0 + T_IN, E2 = E1 + T_FF1, E3 = E2 + T_FF2, E4 = E3 + T_OUT, E5 = E4 + T_BR, E6 = E5 + T_BR, E7 = E6 + T_UQ, E8 = E7 + T_UKV,
                E9 = E8 + 2 * T_L, E10 = E9 + 2 * T_L, E11 = E10 + T_G2;
  for (int it = blockIdx.x; it < E11; it += gridDim.x) {
    if (it < E0) mod_partial_item(p, it, smem);
    else if (it < E1) { const int t = it - E0; conv_item(p.w_in, DIN, (bf16_t*)(ws + OFF_WIN), 1024, t % 10, t / 10, nullptr, DIN, DIN_PAD); }
    else if (it < E2) { const int t = it - E1; conv_item(p.w_ff1, DFF, (bf16_t*)(ws + OFF_WFF1), 1024, t % 8, t / 8, nullptr, DFF, DFF); }
    else if (it < E3) { const int t = it - E2; conv_item(p.w_ff2, DM, (bf16_t*)(ws + OFF_WFF2), DFF, t % 2, t / 2, nullptr, DM, DM); }
    else if (it < E4) { const int t = it - E3; conv_item(p.w_out, DM, (bf16_t*)(ws + OFF_WOUT), DM, t % 2, t / 2, nullptr, DM, DM); }
    else if (it < E5) { const int t = it - E4; conv_item(p.w_br_rwkv, DM, (bf16_t*)(ws + OFF_WBR1), 512, t % 2, t / 2, nullptr, DM, DM); }
    else if (it < E6) { const int t = it - E5; conv_item(p.w_br_mla, DM, (bf16_t*)(ws + OFF_WBR2), 512, t % 2, t / 2, nullptr, DM, DM); }
    else if (it < E7) { const int t = it - E6; conv_item(p.w_uq, 768, (bf16_t*)(ws + OFF_WUQ), 384, t % 2, t / 2, p.q_norm_g, 768, 768); }
    else if (it < E8) { const int t = it - E7; conv_item(p.w_ukv, 1024, (bf16_t*)(ws + OFF_WUKV), 256, t % 2, t / 2, p.kv_norm_g, 1024, 1024); }
    else if (it < E9) { const int t = it - E8, d = t / 8; conv_item(p.rw_w2 + d * 64 * 512, 512, (bf16_t*)(ws + OFF_WW2) + d * 512 * 64, 64, 0, t % 8, nullptr, 512, 512); }
    else if (it < E10) { const int t = it - E9, d = t / 8; conv_item(p.rw_a2 + d * 64 * 512, 512, (bf16_t*)(ws + OFF_WA2) + d * 512 * 64, 64, 0, t % 8, nullptr, 512, 512); }
    else { const int t = it - E10; conv_item(p.rw_g2, 512, (bf16_t*)(ws + OFF_WG2), 128, 0, t, nullptr, 512, 512); }
  }
}

DI void phase0b(const Params& p, char* smem) {
  const float* part = (const float*)(p.ws + OFF_PART);
  float* mod = (float*)(p.ws + OFF_MOD);
  const int tid = tidx();
  for (int m = blockIdx.x; m < 192; m += gridDim.x) {
    const int b = m / 6, seg = m % 6, col = seg * 1024 + (tid & 255) * 4;
    f32x4 v = *(const f32x4*)(p.b_ada + col);
    for (int kc = 0; kc < 16; ++kc) v += *(const f32x4*)(part + ((size_t)kc * 32 + b) * 6144 + col);
    if (tid < 256) *(f32x4*)(mod + b * 6144 + col) = v;
  }
  bf16_t* hbf = (bf16_t*)(p.ws + OFF_HBF);
  for (int t = blockIdx.x; t < NTOK / 128; t += gridDim.x) {
    const int row0 = t * 128, b = row0 / SEQ, col = (tid & 255) * 4;
    f32x4 sh = *(const f32x4*)(p.b_ada + col), sc = *(const f32x4*)(p.b_ada + 1024 + col);
    for (int kc = 0; kc < 16; ++kc) { const float* pp = part + ((size_t)kc * 32 + b) * 6144 + col; sh += *(const f32x4*)pp; sc += *(const f32x4*)(pp + 1024); }
    sc += 1.f;
#pragma unroll 8
    for (int r = tid >> 8; r < 128; r += 2) {
      const f32x4 xv = *(const f32x4*)(p.x + (size_t)(row0 + r) * DM + col);
      const f32x4 h = xv * sc + sh;
      *(u32x2*)(hbf + (size_t)(row0 + r) * DM + col) = (u32x2){pk2(h[0], h[1]), pk2(h[2], h[3])};
    }
  }
}

typedef __attribute__((address_space(3))) unsigned lds_u32_t;
DI void dma16(const void* g, char* l) { __builtin_amdgcn_global_load_lds((const unsigned*)g, (lds_u32_t*)l, 16, 0, 0); }
constexpr int MI = 8;
constexpr int GSTAGE = 32768;
template <bool PERMB = false>
DI void gemm_tile_acc(f32x4 (&acc)[MI][4], const bf16_t* A, int lda, const bf16_t* Bt, int ldb, int m0, int n0, int K, char* smem) {
  const int tid = tidx(), lane = tid & 63, wid = __builtin_amdgcn_readfirstlane(tid >> 6), wm = wid >> 2, wn = wid & 3;
  const int lr = lane >> 2, lch = (lane & 3) ^ ((lane >> 3) & 3);
  const bf16_t* Ag = A + (size_t)(m0 + wid * 32 + lr) * lda + lch * 8;
  const int brow = PERMB ? (8 * (lr >> 2) + (lr & 3)) : lr, bstep = PERMB ? 4 : 16;
  const bf16_t* Bg = Bt + (size_t)(n0 + wid * 32 + brow) * ldb + lch * 8;
  const int nk = K >> 5;
  const int fch = ((lane >> 4) ^ ((lane >> 1) & 3)) << 4;
  const int abase = (wm * 128 + (lane & 15)) * 64 + fch, bbase = 16384 + (wn * 64 + (lane & 15)) * 64 + fch;
  char* swa = smem + wid * 2048;
  char* swb = smem + 16384 + wid * 2048;
#define GEMM_ISSUE(kt_, st_) do { char* da_ = swa + (st_) * GSTAGE; char* db_ = swb + (st_) * GSTAGE; \
    _Pragma("unroll") for (int i_ = 0; i_ < 2; ++i_) dma16(Ag + (size_t)i_ * 16 * lda + (kt_) * 32, da_ + i_ * 1024); \
    _Pragma("unroll") for (int i_ = 0; i_ < 2; ++i_) dma16(Bg + (size_t)i_ * bstep * ldb + (kt_) * 32, db_ + i_ * 1024); } while (0)
  GEMM_ISSUE(0, 0);
  if (nk > 1) GEMM_ISSUE(1, 1);
  int st = 0, st2 = 2;
  for (int kt = 0; kt < nk; ++kt) {
    if (kt + 1 < nk) asm volatile("s_waitcnt vmcnt(4)" ::: "memory"); else asm volatile("s_waitcnt vmcnt(0)" ::: "memory");
    __builtin_amdgcn_s_barrier();
    asm volatile("" ::: "memory");
    const bool issue = kt + 2 < nk;
    char* da = swa + st2 * GSTAGE; char* db = swb + st2 * GSTAGE;
    const bf16_t* ga_ = Ag + (kt + 2) * 32; const bf16_t* gb_ = Bg + (kt + 2) * 32;
    const char* sp = smem + st * GSTAGE;
    bf16x8 bfr[4];
#pragma unroll
    for (int i = 0; i < 4; ++i) bfr[i] = *(const bf16x8*)(sp + bbase + i * 1024);
#pragma unroll
    for (int hf = 0; hf < 2; ++hf) {
      bf16x8 af[4];
#pragma unroll
      for (int i = 0; i < 4; ++i) af[i] = *(const bf16x8*)(sp + abase + (hf * 4 + i) * 1024);
#pragma unroll
      for (int mi = 0; mi < 4; ++mi) {
#pragma unroll
        for (int ni = 0; ni < 4; ++ni) acc[hf * 4 + mi][ni] = __builtin_amdgcn_mfma_f32_16x16x32_bf16(bfr[ni], af[mi], acc[hf * 4 + mi][ni], 0, 0, 0);
        const int pc = hf * 4 + mi;
        if (issue) { if (pc == 0 || pc == 2) dma16(ga_ + (size_t)(pc >> 1) * 16 * lda, da + (pc >> 1) * 1024); else if (pc == 4 || pc == 6) dma16(gb_ + (size_t)((pc - 4) >> 1) * bstep * ldb, db + ((pc - 4) >> 1) * 1024); }
      }
    }
    st = (st == 2) ? 0 : st + 1; st2 = (st2 == 2) ? 0 : st2 + 1;
  }
  asm volatile("s_waitcnt lgkmcnt(0)" ::: "memory");
  __builtin_amdgcn_s_barrier();
  asm volatile("" ::: "memory");
#undef GEMM_ISSUE
}
DI void zero_acc(f32x4 (&acc)[MI][4]) {
#pragma unroll
  for (int i = 0; i < MI; ++i)
#pragma unroll
    for (int j = 0; j < 4; ++j) acc[i][j] = (f32x4){0.f, 0.f, 0.f, 0.f};
}

template <class Epi, bool PERMB = false>
DI void gemm_phase(const bf16_t* A, int lda, const bf16_t* Bt, int ldb, int M, int N, int K, char* smem, const Epi& epi) {
  const int nN = N / 256, nT = (M / 256) * nN;
  const int lane = tidx() & 63, wid = tidx() >> 6;
  const int xg = blockIdx.x & 7, jg = blockIdx.x >> 3, per = gridDim.x >> 3;
  for (int t0 = 0; t0 < nT; t0 += gridDim.x) {
    int t = t0 + xg * per + jg;
    if (nN == 16 && gridDim.x == 256) { const int tmr = (xg >> 1) * 4 + (jg >> 3), tnr = (xg & 1) * 8 + (jg & 7); t = t0 + tmr * 16 + tnr; }
    if (t >= nT) continue;
    const int m0 = (t / nN) * 256, n0 = (t % nN) * 256;
    f32x4 acc[MI][4];
    zero_acc(acc);
    gemm_tile_acc<PERMB>(acc, A, lda, Bt, ldb, m0, n0, K, smem);
    epi(acc, m0 + (wid >> 2) * 128, n0 + (wid & 3) * 64, lane);
  }
}

struct EpiIn {
  char* ws;
  DI void operator()(f32x4 (&acc)[MI][4], int rb, int cb, int lane) const {
    bf16_t *zrw = (bf16_t*)(ws + OFF_ZRW), *zq = (bf16_t*)(ws + OFF_ZQ), *zkv = (bf16_t*)(ws + OFF_ZKV), *zkr = (bf16_t*)(ws + OFF_ZKR), *ga = (bf16_t*)(ws + OFF_GA), *gb = (bf16_t*)(ws + OFF_GB);
#pragma unroll
    for (int ni = 0; ni < 4; ++ni) {
      const int col = cb + ni * 16 + (lane >> 4) * 4;
      if (col >= DIN) continue;
#pragma unroll
      for (int mi = 0; mi < MI; ++mi) {
        int row_ = rb + mi * 16 + (lane & 15); asm volatile("" : "+v"(row_));
        const size_t row = row_;
        f32x4 v = acc[mi][ni];
        bf16_t* d;
        if (col < 1920) d = zrw + row * 1920 + col;
        else if (col < 2304) d = zq + row * 384 + (col - 1920);
        else if (col < 2560) d = zkv + row * 256 + (col - 2304);
        else if (col < 2592) d = zkr + row * 32 + (col - 2560);
        else {
          v = (f32x4){sigm(v[0]), sigm(v[1]), sigm(v[2]), sigm(v[3])};
          d = (col < 3616) ? ga + row * 1024 + (col - 2592) : gb + row * 1024 + (col - 3616);
        }
        *(u32x2*)d = (u32x2){pk2(v[0], v[1]), pk2(v[2], v[3])};
      }
    }
  }
};

constexpr float QSCALE = 0.10206207261596577f * 1.4426950408889634f;
struct EpiQ {
  char* ws;
  DI void operator()(f32x4 (&acc)[MI][4], int rb, int cb, int lane) const {
    bf16_t* Q = (bf16_t*)(ws + OFF_Q); const float* rsq = (const float*)(ws + OFF_RSQ); const float* cs = (const float*)(ws + OFF_CS);
#pragma unroll
    for (int mi = 0; mi < MI; ++mi) {
      int row = rb + mi * 16 + (lane & 15); asm volatile("" : "+v"(row) :: "memory");
      const int b = row / SEQ, s = row % SEQ;
      const float rs = rsq[row] * QSCALE;
#pragma unroll
      for (int ni = 0; ni < 4; ++ni) {
        const int nt = (cb >> 4) + ni, h = nt / 6, sub = nt % 6;
        bf16_t* d = Q + ((size_t)(b * 8 + h) * SEQ + s) * 96;
        const int c4 = (lane >> 4) * 4;
        if (sub < 4) { const f32x4 v = acc[mi][ni] * rs; *(u32x2*)(d + sub * 16 + c4) = (u32x2){pk2(v[0], v[1]), pk2(v[2], v[3])}; }
        else if (sub == 4) {
          if (ni < 3) {
            const f32x4 x1 = acc[mi][ni] * rs, x2 = acc[mi][ni + 1 < 4 ? ni + 1 : 3] * rs;
            const f32x4 co = *(const f32x4*)(cs + (size_t)row * 32 + c4), si = *(const f32x4*)(cs + (size_t)row * 32 + 16 + c4);
            const f32x4 o1 = x1 * co - x2 * si, o2 = x1 * si + x2 * co;
            *(u32x2*)(d + 64 + c4) = (u32x2){pk2(o1[0], o1[1]), pk2(o1[2], o1[3])};
            *(u32x2*)(d + 80 + c4) = (u32x2){pk2(o2[0], o2[1]), pk2(o2[2], o2[3])};
          }
        }
      }
    }
  }
};
struct EpiKV {
  char* ws;
  DI void operator()(f32x4 (&acc)[MI][4], int rb, int cb, int lane) const {
    bf16_t* Kn = (bf16_t*)(ws + OFF_KN); bf16_t* VT = (bf16_t*)(ws + OFF_VT); const float* rskv = (const float*)(ws + OFF_RSKV);
    const int h = cb >> 7, isv = (cb >> 6) & 1;
#pragma unroll
    for (int mi = 0; mi < MI; ++mi) {
      int row = rb + mi * 16 + (lane & 15); asm volatile("" : "+v"(row) :: "memory");
      const int b = row / SEQ, s = row % SEQ;
      const float rs = rskv[row];
#pragma unroll
      for (int ni = 0; ni < 4; ++ni) {
        const int d0 = ni * 16 + (lane >> 4) * 4;
        const f32x4 v = acc[mi][ni] * rs;
        if (!isv) *(u32x2*)(Kn + ((size_t)(b * 8 + h) * SEQ + s) * 64 + d0) = (u32x2){pk2(v[0], v[1]), pk2(v[2], v[3])};
        else {
          bf16_t* d = VT + ((size_t)(b * 8 + h) * 64 + d0) * SEQ + s;
          d[0] = f2bf(v[0]); d[SEQ] = f2bf(v[1]); d[2 * SEQ] = f2bf(v[2]); d[3 * SEQ] = f2bf(v[3]);
        }
      }
    }
  }
};
struct EpiG {
  char* ws; const float *lnx_g, *lnx_b;
  DI void operator()(f32x4 (&acc)[MI][4], int rb, int cb, int lane) const {
    const bf16_t *yf = (const bf16_t*)(ws + OFF_YF), *yb = (const bf16_t*)(ws + OFF_YB), *V = (const bf16_t*)(ws + OFF_V);
    const float* rkdot = (const float*)(ws + OFF_RKDOT); bf16_t* yrw = (bf16_t*)(ws + OFF_YRW);
    const int h = cb >> 6;
#pragma unroll
    for (int mi = 0; mi < MI; ++mi) {
      int row_ = rb + mi * 16 + (lane & 15); asm volatile("" : "+v"(row_) :: "memory");
      const size_t row = row_;
      f32x4 y[4]; float sum = 0.f;
#pragma unroll
      for (int ni = 0; ni < 4; ++ni) {
        const size_t o = row * 512 + cb + ni * 16 + (lane >> 4) * 4;
        const u32x2 a = *(const u32x2*)(yf + o), b2 = *(const u32x2*)(yb + o);
        y[ni] = (f32x4){bflo(a[0]) + bflo(b2[0]), bfhi(a[0]) + bfhi(b2[0]), bflo(a[1]) + bflo(b2[1]), bfhi(a[1]) + bfhi(b2[1])};
        sum += (y[ni][0] + y[ni][1]) + (y[ni][2] + y[ni][3]);
      }
      sum += __shfl_xor(sum, 16); sum += __shfl_xor(sum, 32);
      const float mean = sum * (1.f / 64.f);
      float q = 0.f;
#pragma unroll
      for (int ni = 0; ni < 4; ++ni) { const f32x4 dd = y[ni] - mean; q += (dd[0] * dd[0] + dd[1] * dd[1]) + (dd[2] * dd[2] + dd[3] * dd[3]); }
      q += __shfl_xor(q, 16); q += __shfl_xor(q, 32);
      const float rstd = rsqrtf(q * (1.f / 64.f) + 64e-5f);
      const float rk = rkdot[row * 8 + h];
#pragma unroll
      for (int ni = 0; ni < 4; ++ni) {
        const int col = cb + ni * 16 + (lane >> 4) * 4;
        const f32x4 g = *(const f32x4*)(lnx_g + col), be = *(const f32x4*)(lnx_b + col);
        const u32x2 vv = *(const u32x2*)(V + row * 512 + col);
        const f32x4 vf = (f32x4){bflo(vv[0]), bfhi(vv[0]), bflo(vv[1]), bfhi(vv[1])};
        const f32x4 o = ((y[ni] - mean) * rstd * g + be + vf * rk) * acc[mi][ni];
        *(u32x2*)(yrw + row * 512 + col) = (u32x2){pk2(o[0], o[1]), pk2(o[2], o[3])};
      }
      asm volatile("" ::: "memory");
    }
  }
};
struct EpiG8 {
  char* ws; const float *lnx_g, *lnx_b;
  DI void operator()(f32x4 (&acc)[MI][4], int rb, int cb, int lane) const {
    const bf16_t *yf = (const bf16_t*)(ws + OFF_YF), *yb = (const bf16_t*)(ws + OFF_YB), *V = (const bf16_t*)(ws + OFF_V);
    const float* rkdot = (const float*)(ws + OFF_RKDOT); bf16_t* yrw = (bf16_t*)(ws + OFF_YRW);
    const int h = cb >> 6;
#pragma unroll
    for (int mi = 0; mi < MI; ++mi) {
      int row_ = rb + mi * 16 + (lane & 15); asm volatile("" : "+v"(row_));
      const size_t row = row_;
      f32x4 y[4]; float sum = 0.f;
      u32x4 vv2[2];
#pragma unroll
      for (int pr = 0; pr < 2; ++pr) vv2[pr] = *(const u32x4*)(V + row * 512 + cb + pr * 32 + (lane >> 4) * 8);
      const float rk = rkdot[row * 8 + h];
#pragma unroll
      for (int pr = 0; pr < 2; ++pr) {
        const size_t o = row * 512 + cb + pr * 32 + (lane >> 4) * 8;
        const u32x4 a = *(const u32x4*)(yf + o), b2 = *(const u32x4*)(yb + o);
        y[2 * pr] = (f32x4){bflo(a[0]) + bflo(b2[0]), bfhi(a[0]) + bfhi(b2[0]), bflo(a[1]) + bflo(b2[1]), bfhi(a[1]) + bfhi(b2[1])};
        y[2 * pr + 1] = (f32x4){bflo(a[2]) + bflo(b2[2]), bfhi(a[2]) + bfhi(b2[2]), bflo(a[3]) + bflo(b2[3]), bfhi(a[3]) + bfhi(b2[3])};
        sum += ((y[2 * pr][0] + y[2 * pr][1]) + (y[2 * pr][2] + y[2 * pr][3])) + ((y[2 * pr + 1][0] + y[2 * pr + 1][1]) + (y[2 * pr + 1][2] + y[2 * pr + 1][3]));
      }
      sum += __shfl_xor(sum, 16); sum += __shfl_xor(sum, 32);
      const float mean = sum * (1.f / 64.f);
      float q = 0.f;
#pragma unroll
      for (int ni = 0; ni < 4; ++ni) { const f32x4 dd = y[ni] - mean; q += (dd[0] * dd[0] + dd[1] * dd[1]) + (dd[2] * dd[2] + dd[3] * dd[3]); }
      q += __shfl_xor(q, 16); q += __shfl_xor(q, 32);
      const float rstd = rsqrtf(q * (1.f / 64.f) + 64e-5f);
#pragma unroll
      for (int pr = 0; pr < 2; ++pr) {
        const int col = cb + pr * 32 + (lane >> 4) * 8;
        const u32x4 vv = vv2[pr];
        const f32x4 g0 = *(const f32x4*)(lnx_g + col), g1 = *(const f32x4*)(lnx_g + col + 4), be0 = *(const f32x4*)(lnx_b + col), be1 = *(const f32x4*)(lnx_b + col + 4);
        const f32x4 v0 = (f32x4){bflo(vv[0]), bfhi(vv[0]), bflo(vv[1]), bfhi(vv[1])}, v1 = (f32x4){bflo(vv[2]), bfhi(vv[2]), bflo(vv[3]), bfhi(vv[3])};
        const f32x4 o0 = ((y[2 * pr] - mean) * rstd * g0 + be0 + v0 * rk) * acc[mi][2 * pr];
        const f32x4 o1 = ((y[2 * pr + 1] - mean) * rstd * g1 + be1 + v1 * rk) * acc[mi][2 * pr + 1];
        *(u32x4*)(yrw + row * 512 + col) = (u32x4){pk2(o0[0], o0[1]), pk2(o0[2], o0[3]), pk2(o1[0], o1[1]), pk2(o1[2], o1[3])};
      }
      if (mi & 1) asm volatile("" ::: "memory");
    }
  }
};
struct EpiRes {
  const float* base; const float* gate; float* out;
  DI void operator()(f32x4 (&acc)[MI][4], int rb, int cb, int lane) const {
#pragma unroll
    for (int mi = 0; mi < MI; ++mi) {
      int row_ = rb + mi * 16 + (lane & 15); asm volatile("" : "+v"(row_) :: "memory");
      const size_t row = row_; const int b = (int)(row / SEQ);
#pragma unroll
      for (int ni = 0; ni < 4; ++ni) {
        const int col = cb + ni * 16 + (lane >> 4) * 4;
        const f32x4 g = *(const f32x4*)(gate + b * 6144 + col) + 1.f;
        const f32x4 xb = *(const f32x4*)(base + row * DM + col);
        *(f32x4*)(out + row * DM + col) = xb * DN_ALPHA + g * acc[mi][ni];
      }
      asm volatile("" ::: "memory");
    }
  }
};
struct EpiRelu2 {
  bf16_t* out;
  DI void operator()(f32x4 (&acc)[MI][4], int rb, int cb, int lane) const {
#pragma unroll
    for (int mi = 0; mi < MI; ++mi) {
      int row_ = rb + mi * 16 + (lane & 15); asm volatile("" : "+v"(row_) :: "memory");
      const size_t row = row_;
#pragma unroll
      for (int ni = 0; ni < 4; ++ni) {
        const int col = cb + ni * 16 + (lane >> 4) * 4;
        f32x4 v = acc[mi][ni];
#pragma unroll
        for (int j = 0; j < 4; ++j) { const float r = fmaxf(v[j], 0.f); v[j] = r * r; }
        *(u32x2*)(out + row * DFF + col) = (u32x2){pk2(v[0], v[1]), pk2(v[2], v[3])};
      }
    }
  }
};

namespace pg8 {
#define PG8_LAS __attribute__((address_space(3)))
typedef unsigned short bf16_t;
typedef short bf16x8 __attribute__((ext_vector_type(8)));
typedef float f32x4 __attribute__((ext_vector_type(4)));
typedef unsigned u32x4 __attribute__((ext_vector_type(4)));
constexpr int BM = 256, BK = 64, HALF = 128, HTB = HALF * BK * 2  , STAGE_BYTES = 8 * HTB, NXCD = 8, WGM = 8;

__host__ __device__ __forceinline__ int lds_byte(int r, int c) { const int st = (r >> 4) * 2 + (c >> 5), rr = r & 15, cc = c & 31, ob = rr * 64 + cc * 2; return st * 1024 + (ob ^ (((ob >> 9) & 1) << 5)); }
__host__ __device__ __forceinline__ void stage_rc(int b, int& R, int& C) { const int st = b / 1024, sb = b % 1024, swz = sb ^ (((sb >> 9) & 1) << 5); R = (st >> 1) * 16 + swz / 64; C = (st & 1) * 32 + (swz % 64) / 2; }
__host__ __device__ __forceinline__ int perm32(int rho) { const int n = rho >> 4, i = rho & 15; return 8 * (i >> 2) + 4 * n + (i & 3); }

struct Unit { int pm, pn; };
struct Gemm { const bf16_t* A; const bf16_t* Bt; int M, N, K; };

struct StaticOrder {
    int nM, nN, nwg, G, c;
    __host__ __device__ void init(int M, int N, int G_, int c_) { nM = M / BM; nN = N / BM; nwg = nM * nN; G = G_; c = c_; }
    __host__ __device__ bool next(int i, Unit& u) const {
        const long L = (long)i * G + c; if (L >= nwg) return false;
        int wgid = (int)L; { const int q = nwg / NXCD, r = nwg % NXCD, xcd = wgid % NXCD, off = wgid / NXCD; wgid = (xcd < r ? xcd * (q + 1) : r * (q + 1) + (xcd - r) * q) + off; }
        const int nig = WGM * nN, gid = wgid / nig, fm = gid * WGM, gsz = (nM - fm) < WGM ? (nM - fm) : WGM;
        u.pm = fm + ((wgid % nig) % gsz); u.pn = (wgid % nig) / gsz; return true;
    }
    __device__ __forceinline__ void a_ready(const Unit&) const {}
    __device__ __forceinline__ void done(const Unit&) const {}
};

template <class Epi, class Sched, bool ALIGN_EPI = false, bool SP2 = false>
__device__ __forceinline__ void gemm_phase(PG8_LAS unsigned char* lds, const Gemm g, const Sched& S, const Epi& E) {
    const int tid = ::tidx(), wid = __builtin_amdgcn_readfirstlane(tid >> 6), lane = tid & 63, wr = wid >> 2, wc = wid & 3, fr = lane & 15, fq = lane >> 4;
    const int K = g.K, nt = K / BK;
    unsigned voffA[2], voffB[2];
#pragma unroll
    for (int i = 0; i < 2; ++i) { int R, C; stage_rc(tid * 16 + i * 8192, R, C); const int Rb = Epi::PERM ? ((R & ~31) + perm32(R & 31)) : R;
        voffA[i] = (unsigned)(R * K + C) * 2u; voffB[i] = (unsigned)(Rb * K + C) * 2u; }
    const size_t kstep = (size_t)(BK * 2);
    const size_t hstep = (size_t)HALF * K * 2;
    const size_t tstep = 2 * hstep;
    const unsigned ldsw = (unsigned)wid * 1024u;
    const int aoff = lds_byte(wr * 64 + fr, fq * 8), boff = lds_byte(wc * 32 + fr, fq * 8);
#define PG8_SA(b, h) (((b) * 2 + (h)) * HTB)
#define PG8_SB(b, h) ((4 + (b) * 2 + (h)) * HTB)
#define PG8_STAGE(bufoff, gbase, voff) do { _Pragma("unroll") for (int _i = 0; _i < 2; ++_i) \
        __builtin_amdgcn_global_load_lds((const unsigned*)((const char*)(gbase) + (voff)[_i]), (PG8_LAS unsigned*)(lds + (bufoff) + ldsw + _i * 8192), 16, 0, 0); } while (0)
#define PG8_LDA(dst, b, h) do { _Pragma("unroll") for (int m = 0; m < 4; ++m) _Pragma("unroll") for (int k = 0; k < 2; ++k) dst[m][k] = *(const PG8_LAS bf16x8*)(lds + PG8_SA(b, h) + aoff + m * 2048 + k * 1024); } while (0)
#define PG8_LDB(dst, b, h) do { _Pragma("unroll") for (int n = 0; n < 2; ++n) _Pragma("unroll") for (int k = 0; k < 2; ++k) dst[n][k] = *(const PG8_LAS bf16x8*)(lds + PG8_SB(b, h) + boff + n * 2048 + k * 1024); } while (0)
#define PG8_MMA(ai, bj, At, Bt) do { __builtin_amdgcn_s_setprio(1); _Pragma("unroll") for (int m = 0; m < 4; ++m) _Pragma("unroll") for (int n = 0; n < 2; ++n) _Pragma("unroll") for (int k = 0; k < 2; ++k) \
        acc[ai][bj][m][n] = __builtin_amdgcn_mfma_f32_16x16x32_bf16(Bt[n][k], At[m][k], acc[ai][bj][m][n], 0, 0, 0); __builtin_amdgcn_s_setprio(0); } while (0)
#define PG8_WAIT_V(n) asm volatile("s_waitcnt vmcnt(" #n ")" ::: "memory")
#define PG8_WAIT_L(n) asm volatile("s_waitcnt lgkmcnt(" #n ")" ::: "memory")
#define PG8_BAR __builtin_amdgcn_s_barrier()
#define PG8_SCHED __builtin_amdgcn_sched_barrier(0)
    Unit cur, nxt; int ui = 0;
    if (!S.next(0, cur)) return;
    f32x4 acc[2][2][4][2];
#pragma unroll
    for (int a = 0; a < 2; ++a)
#pragma unroll
        for (int b = 0; b < 2; ++b)
#pragma unroll
            for (int m = 0; m < 4; ++m)
#pragma unroll
                for (int n = 0; n < 2; ++n) acc[a][b][m][n] = (f32x4){0.f, 0.f, 0.f, 0.f};
    bf16x8 At[4][2], B0[2][2], B1[2][2];
    const char* cA = (const char*)g.A + (size_t)cur.pm * tstep; const char* cB = (const char*)g.Bt + (size_t)cur.pn * tstep;
    S.a_ready(cur);
    if constexpr (SP2) {
        PG8_STAGE(PG8_SB(0, 0), cB, voffB); PG8_STAGE(PG8_SB(0, 1), cB + hstep, voffB); PG8_STAGE(PG8_SA(0, 0), cA, voffA); PG8_STAGE(PG8_SA(0, 1), cA + hstep, voffA);
        if (wr == 1) PG8_BAR;
        PG8_WAIT_V(2); PG8_BAR;
        PG8_STAGE(PG8_SB(1, 0), cB + kstep, voffB); PG8_STAGE(PG8_SA(1, 0), cA + kstep, voffA); PG8_STAGE(PG8_SB(1, 1), cB + hstep + kstep, voffB);
        PG8_WAIT_V(6); PG8_BAR;
    } else {
        PG8_STAGE(PG8_SB(0, 0), cB, voffB); PG8_STAGE(PG8_SA(0, 0), cA, voffA); PG8_STAGE(PG8_SB(0, 1), cB + hstep, voffB); PG8_STAGE(PG8_SA(0, 1), cA + hstep, voffA);
        if (wr == 1) PG8_BAR;
        PG8_WAIT_V(4); PG8_BAR;
        PG8_STAGE(PG8_SB(1, 0), cB + kstep, voffB); PG8_STAGE(PG8_SA(1, 0), cA + kstep, voffA); PG8_STAGE(PG8_SB(1, 1), cB + hstep + kstep, voffB);
        PG8_WAIT_V(6); PG8_BAR;
    }
    for (;;) {
        const bool has_next = S.next(ui + 1, nxt);
        const char* nA = has_next ? (const char*)g.A + (size_t)nxt.pm * tstep : cA; const char* nB = has_next ? (const char*)g.Bt + (size_t)nxt.pn * tstep : cB;
        for (int t = 0; t < nt; t += 2) {
            const bool last = (t == nt - 2);
            const char* a1 = cA + (size_t)(t + 1) * kstep;
            const char* a2 = last ? nA : cA + (size_t)(t + 2) * kstep; const char* b2 = last ? nB : cB + (size_t)(t + 2) * kstep;
            const char* a3 = a2 + kstep; const char* b3 = b2 + kstep;
            if (last && has_next) S.a_ready(nxt);
            if constexpr (SP2) {
            PG8_LDB(B0, 0, 0); PG8_LDB(B1, 0, 1); PG8_SCHED; PG8_LDA(At, 0, 0); PG8_STAGE(PG8_SA(1, 1), a1 + hstep, voffA);
            PG8_WAIT_V(8); PG8_WAIT_L(0); PG8_BAR; PG8_MMA(0, 0, At, B0); PG8_MMA(0, 1, At, B1); PG8_BAR; PG8_SCHED;
            PG8_LDA(At, 0, 1); PG8_STAGE(PG8_SB(0, 0), b2, voffB); PG8_STAGE(PG8_SB(0, 1), b2 + hstep, voffB); PG8_STAGE(PG8_SA(0, 0), a2, voffA);
            PG8_WAIT_V(8); PG8_WAIT_L(0); PG8_BAR; PG8_MMA(1, 0, At, B0); PG8_MMA(1, 1, At, B1); PG8_BAR; PG8_SCHED;
            PG8_LDB(B0, 1, 0); PG8_LDB(B1, 1, 1); PG8_SCHED; PG8_LDA(At, 1, 0); PG8_STAGE(PG8_SA(0, 1), a2 + hstep, voffA);
            PG8_WAIT_V(8); PG8_WAIT_L(0); PG8_BAR; PG8_MMA(0, 0, At, B0); PG8_MMA(0, 1, At, B1); PG8_BAR; PG8_SCHED;
            PG8_LDA(At, 1, 1); PG8_STAGE(PG8_SB(1, 0), b3, voffB); PG8_STAGE(PG8_SB(1, 1), b3 + hstep, voffB); PG8_STAGE(PG8_SA(1, 0), a3, voffA);
            PG8_WAIT_V(8); PG8_WAIT_L(0); PG8_BAR; PG8_MMA(1, 0, At, B0); PG8_MMA(1, 1, At, B1); PG8_BAR; PG8_SCHED;
            } else {
            PG8_LDB(B0, 0, 0); PG8_SCHED; PG8_LDA(At, 0, 0); PG8_STAGE(PG8_SA(1, 1), a1 + hstep, voffA);
            PG8_WAIT_L(8); PG8_BAR; PG8_WAIT_L(0); PG8_MMA(0, 0, At, B0); PG8_BAR; PG8_SCHED;
            PG8_LDB(B1, 0, 1); PG8_STAGE(PG8_SB(0, 0), b2, voffB);
            PG8_BAR; PG8_WAIT_L(0); PG8_MMA(0, 1, At, B1); PG8_BAR;
            PG8_LDA(At, 0, 1); PG8_STAGE(PG8_SA(0, 0), a2, voffA);
            PG8_BAR; PG8_WAIT_L(0); PG8_MMA(1, 0, At, B0); PG8_BAR; PG8_SCHED;
            PG8_STAGE(PG8_SB(0, 1), b2 + hstep, voffB);
            PG8_WAIT_V(6); PG8_BAR; PG8_MMA(1, 1, At, B1); PG8_BAR;
            PG8_LDB(B0, 1, 0); PG8_SCHED; PG8_LDA(At, 1, 0); PG8_STAGE(PG8_SA(0, 1), a2 + hstep, voffA);
            PG8_WAIT_L(8); PG8_BAR; PG8_WAIT_L(0); PG8_MMA(0, 0, At, B0); PG8_BAR; PG8_SCHED;
            PG8_LDB(B1, 1, 1); PG8_STAGE(PG8_SB(1, 0), b3, voffB);
            PG8_BAR; PG8_WAIT_L(0); PG8_MMA(0, 1, At, B1); PG8_BAR;
            PG8_LDA(At, 1, 1); PG8_STAGE(PG8_SA(1, 0), a3, voffA);
            PG8_BAR; PG8_WAIT_L(0); PG8_MMA(1, 0, At, B0); PG8_BAR; PG8_SCHED;
            PG8_STAGE(PG8_SB(1, 1), b3 + hstep, voffB);
            PG8_WAIT_V(6); PG8_BAR; PG8_MMA(1, 1, At, B1); PG8_BAR;
            }
        }
        if constexpr (ALIGN_EPI) { if (wr == 0) PG8_BAR; }
        if constexpr (!Epi::AFTER_DRAIN) { E(acc, cur, wr, wc, fr, fq); S.done(cur); }
        if (!has_next) break;
#pragma unroll
        for (int a = 0; a < 2; ++a)
#pragma unroll
            for (int b = 0; b < 2; ++b)
#pragma unroll
                for (int m = 0; m < 4; ++m)
#pragma unroll
                    for (int n = 0; n < 2; ++n) acc[a][b][m][n] = (f32x4){0.f, 0.f, 0.f, 0.f};
        cur = nxt; cA = nA; cB = nB; ++ui;
        if constexpr (ALIGN_EPI) { if (wr == 1) PG8_BAR; }
    }
    PG8_WAIT_V(0);
    if constexpr (!ALIGN_EPI) { if (wr == 0) PG8_BAR; }
    PG8_BAR;
    if constexpr (Epi::AFTER_DRAIN) { E.fused(acc, cur, wr, wc, fr, fq, lds, wid, lane); S.done(cur); }
#undef PG8_SA
#undef PG8_SB
#undef PG8_STAGE
#undef PG8_LDA
#undef PG8_LDB
#undef PG8_MMA
#undef PG8_WAIT_V
#undef PG8_WAIT_L
#undef PG8_BAR
#undef PG8_SCHED
}
}

template <class F> struct PgEpi {
  static constexpr bool PERM = false, AFTER_DRAIN = false;
  F f;
  __device__ __forceinline__ void operator()(const pg8::f32x4 (&acc)[2][2][4][2], const pg8::Unit& u, int wr, int wc, int fr, int fq) const {
#pragma unroll
    for (int ai = 0; ai < 2; ++ai)
#pragma unroll
      for (int m = 0; m < 4; ++m) {
        int row = u.pm * 256 + ai * 128 + wr * 64 + m * 16 + fr; asm volatile("" : "+v"(row));
#pragma unroll
        for (int bj = 0; bj < 2; ++bj)
#pragma unroll
          for (int n = 0; n < 2; ++n) {
            const int col = u.pn * 256 + bj * 128 + wc * 32 + n * 16 + fq * 4;
            const pg8::f32x4 a = acc[ai][bj][m][n];
            f.elem(row, col, (f32x4){a[0], a[1], a[2], a[3]});
          }
        if (m & 1) asm volatile("" ::: "memory");
      }
  }
};
struct InElem {
  char* ws;
  DI void elem8(int row_, int col, f32x4 v, f32x4 w) const {
    if (col >= DIN) return;
    const size_t row = row_;
    bf16_t* d;
    if (col < 1920) d = (bf16_t*)(ws + OFF_ZRW) + row * 1920 + col;
    else if (col < 2304) d = (bf16_t*)(ws + OFF_ZQ) + row * 384 + (col - 1920);
    else if (col < 2560) d = (bf16_t*)(ws + OFF_ZKV) + row * 256 + (col - 2304);
    else if (col < 2592) d = (bf16_t*)(ws + OFF_ZKR) + row * 32 + (col - 2560);
    else {
      v = (f32x4){sigm(v[0]), sigm(v[1]), sigm(v[2]), sigm(v[3])}; w = (f32x4){sigm(w[0]), sigm(w[1]), sigm(w[2]), sigm(w[3])};
      d = (col < 3616) ? (bf16_t*)(ws + OFF_GA) + row * 1024 + (col - 2592) : (bf16_t*)(ws + OFF_GB) + row * 1024 + (col - 3616);
    }
    *(u32x4*)d = (u32x4){pk2(v[0], v[1]), pk2(v[2], v[3]), pk2(w[0], w[1]), pk2(w[2], w[3])};
  }
  DI void elem(int row_, int col, f32x4 v) const {
    if (col >= DIN) return;
    const size_t row = row_;
    bf16_t* d;
    if (col < 1920) d = (bf16_t*)(ws + OFF_ZRW) + row * 1920 + col;
    else if (col < 2304) d = (bf16_t*)(ws + OFF_ZQ) + row * 384 + (col - 1920);
    else if (col < 2560) d = (bf16_t*)(ws + OFF_ZKV) + row * 256 + (col - 2304);
    else if (col < 2592) d = (bf16_t*)(ws + OFF_ZKR) + row * 32 + (col - 2560);
    else {
      v = (f32x4){sigm(v[0]), sigm(v[1]), sigm(v[2]), sigm(v[3])};
      d = (col < 3616) ? (bf16_t*)(ws + OFF_GA) + row * 1024 + (col - 2592) : (bf16_t*)(ws + OFF_GB) + row * 1024 + (col - 3616);
    }
    *(u32x2*)d = (u32x2){pk2(v[0], v[1]), pk2(v[2], v[3])};
  }
};
struct Relu2Elem {
  bf16_t* out;
  DI void elem8(int row_, int col, f32x4 v, f32x4 w) const {
#pragma unroll
    for (int j = 0; j < 4; ++j) { const float r = fmaxf(v[j], 0.f); v[j] = r * r; const float q = fmaxf(w[j], 0.f); w[j] = q * q; }
    *(u32x4*)(out + (size_t)row_ * DFF + col) = (u32x4){pk2(v[0], v[1]), pk2(v[2], v[3]), pk2(w[0], w[1]), pk2(w[2], w[3])};
  }
  DI void elem(int row_, int col, f32x4 v) const {
#pragma unroll
    for (int j = 0; j < 4; ++j) { const float r = fmaxf(v[j], 0.f); v[j] = r * r; }
    *(u32x2*)(out + (size_t)row_ * DFF + col) = (u32x2){pk2(v[0], v[1]), pk2(v[2], v[3])};
  }
};
struct ResElem {
  const float* base; const float* gate; float* out;
  DI void elem(int row_, int col, f32x4 v) const {
    const size_t row = row_; const int b = row_ / SEQ;
    const f32x4 g = *(const f32x4*)(gate + b * 6144 + col) + 1.f;
    const f32x4 xb = *(const f32x4*)(base + row * DM + col);
    *(f32x4*)(out + row * DM + col) = xb * DN_ALPHA + g * v;
  }
};
template <class F> struct PgEpi8 {
  static constexpr bool PERM = true, AFTER_DRAIN = false;
  F f;
  __device__ __forceinline__ void operator()(const pg8::f32x4 (&acc)[2][2][4][2], const pg8::Unit& u, int wr, int wc, int fr, int fq) const {
#pragma unroll
    for (int ai = 0; ai < 2; ++ai)
#pragma unroll
      for (int m = 0; m < 4; ++m) {
        int row = u.pm * 256 + ai * 128 + wr * 64 + m * 16 + fr; asm volatile("" : "+v"(row));
#pragma unroll
        for (int bj = 0; bj < 2; ++bj) {
          const int col = u.pn * 256 + bj * 128 + wc * 32 + fq * 8;
          const pg8::f32x4 a = acc[ai][bj][m][0], b = acc[ai][bj][m][1];
          f.elem8(row, col, (f32x4){a[0], a[1], a[2], a[3]}, (f32x4){b[0], b[1], b[2], b[3]});
        }
        if (m & 1) asm volatile("" ::: "memory");
      }
  }
};
struct MixElem {
  const bf16_t* gate; bf16_t* mixed; int pass;
  DI void elem8(int row_, int col, f32x4 v, f32x4 w) const {
    const size_t o = (size_t)row_ * DM + col;
    const u32x4 g = *(const u32x4*)(gate + o);
    v *= (f32x4){bflo(g[0]), bfhi(g[0]), bflo(g[1]), bfhi(g[1])}; w *= (f32x4){bflo(g[2]), bfhi(g[2]), bflo(g[3]), bfhi(g[3])};
    if (pass) { const u32x4 mm = *(const u32x4*)(mixed + o);
      v += (f32x4){bflo(mm[0]), bfhi(mm[0]), bflo(mm[1]), bfhi(mm[1])}; w += (f32x4){bflo(mm[2]), bfhi(mm[2]), bflo(mm[3]), bfhi(mm[3])}; }
    *(u32x4*)(mixed + o) = (u32x4){pk2(v[0], v[1]), pk2(v[2], v[3]), pk2(w[0], w[1]), pk2(w[2], w[3])};
  }
};
struct T1bElem {
  const float* base; const float* gate; bf16_t* out;
  DI void elem8(int row_, int col, f32x4 v, f32x4 w) const {
    const size_t row = row_; const int b = row_ / SEQ;
    const f32x4 g0 = *(const f32x4*)(gate + b * 6144 + col) + 1.f, g1 = *(const f32x4*)(gate + b * 6144 + col + 4) + 1.f;
    const f32x4 x0 = *(const f32x4*)(base + row * DM + col), x1 = *(const f32x4*)(base + row * DM + col + 4);
    const f32x4 t0 = x0 * DN_ALPHA + g0 * v, t1 = x1 * DN_ALPHA + g1 * w;
    *(u32x4*)(out + row * DM + col) = (u32x4){pk2(t0[0], t0[1]), pk2(t0[2], t0[3]), pk2(t1[0], t1[1]), pk2(t1[2], t1[3])};
  }
};
struct Res2bElem {
  const bf16_t* t1; const float* stats; const float *g1, *b1; const float* gate; bf16_t* out;
  DI void elem8(int row_, int col, f32x4 v, f32x4 w) const {
    const size_t row = row_; const int b = row_ / SEQ;
    const f32x2 st = *(const f32x2*)(stats + row * 2);
    const u32x4 tt = *(const u32x4*)(t1 + row * DM + col);
    const f32x4 ta = (f32x4){bflo(tt[0]), bfhi(tt[0]), bflo(tt[1]), bfhi(tt[1])}, tb = (f32x4){bflo(tt[2]), bfhi(tt[2]), bflo(tt[3]), bfhi(tt[3])};
    const f32x4 xa = (ta - st[0]) * st[1] * *(const f32x4*)(g1 + col) + *(const f32x4*)(b1 + col);
    const f32x4 xb = (tb - st[0]) * st[1] * *(const f32x4*)(g1 + col + 4) + *(const f32x4*)(b1 + col + 4);
    const f32x4 ga = *(const f32x4*)(gate + b * 6144 + col) + 1.f, gb = *(const f32x4*)(gate + b * 6144 + col + 4) + 1.f;
    const f32x4 oa = xa * DN_ALPHA + ga * v, ob = xb * DN_ALPHA + gb * w;
    *(u32x4*)(out + row * DM + col) = (u32x4){pk2(oa[0], oa[1]), pk2(oa[2], oa[3]), pk2(ob[0], ob[1]), pk2(ob[2], ob[3])};
  }
};
template <class F>
DI void pg8_gemm8(char* smem, const bf16_t* A, const bf16_t* Bt, int M, int N, int K, const F& f) {
  pg8::StaticOrder S; S.init(M, N, (int)gridDim.x, (int)blockIdx.x);
  PgEpi8<F> E{f};
  pg8::gemm_phase<PgEpi8<F>, pg8::StaticOrder, true, true>((PG8_LAS unsigned char*)smem, pg8::Gemm{A, Bt, M, N, K}, S, E);
}
struct Res2Elem {
  const float* t1; const float* stats; const float *g1, *b1; const float* gate; float* out;
  DI void elem(int row_, int col, f32x4 v) const {
    const size_t row = row_; const int b = row_ / SEQ;
    const f32x2 st = *(const f32x2*)(stats + row * 2);
    const f32x4 x1 = (*(const f32x4*)(t1 + row * DM + col) - st[0]) * st[1] * *(const f32x4*)(g1 + col) + *(const f32x4*)(b1 + col);
    const f32x4 g = *(const f32x4*)(gate + b * 6144 + col) + 1.f;
    *(f32x4*)(out + row * DM + col) = x1 * DN_ALPHA + g * v;
  }
};
template <class F>
DI void pg8_gemm(char* smem, const bf16_t* A, const bf16_t* Bt, int M, int N, int K, const F& f) {
  pg8::StaticOrder S; S.init(M, N, (int)gridDim.x, (int)blockIdx.x);
  PgEpi<F> E{f};
  pg8::gemm_phase<PgEpi<F>, pg8::StaticOrder, true, true>((PG8_LAS unsigned char*)smem, pg8::Gemm{A, Bt, M, N, K}, S, E);
}

DI void conv8(float (&o)[8], const bf16_t* zrow, int col, bool hp, bool hn, const float* __restrict__ cw) {
  const u32x4 zc = *(const u32x4*)(zrow + col);
  u32x4 zp = (u32x4){0, 0, 0, 0}, zn = (u32x4){0, 0, 0, 0};
  if (hp) zp = *(const u32x4*)(zrow - 1920 + col);
  if (hn) zn = *(const u32x4*)(zrow + 1920 + col);
#pragma unroll
  for (int e = 0; e < 4; ++e) {
    const f32x2 w0 = *(const f32x2*)(cw + col + 2 * e), w1 = *(const f32x2*)(cw + 1920 + col + 2 * e), w2 = *(const f32x2*)(cw + 3840 + col + 2 * e);
    o[2 * e] = w0[0] * bflo(zp[e]) + w1[0] * bflo(zc[e]) + w2[0] * bflo(zn[e]);
    o[2 * e + 1] = w0[1] * bfhi(zp[e]) + w1[1] * bfhi(zc[e]) + w2[1] * bfhi(zn[e]);
  }
}
DI void load_cw(float (&w)[24], const float* __restrict__ cw, int col) {
#pragma unroll
  for (int j = 0; j < 3; ++j)
#pragma unroll
    for (int e = 0; e < 4; ++e) { const f32x2 t = *(const f32x2*)(cw + j * 1920 + col + 2 * e); w[j * 8 + 2 * e] = t[0]; w[j * 8 + 2 * e + 1] = t[1]; }
}
DI void conv8w(float (&o)[8], const bf16_t* zrow, int col, bool hp, bool hn, const float (&w)[24]) {
  const u32x4 zc = *(const u32x4*)(zrow + col);
  u32x4 zp = (u32x4){0, 0, 0, 0}, zn = (u32x4){0, 0, 0, 0};
  if (hp) zp = *(const u32x4*)(zrow - 1920 + col);
  if (hn) zn = *(const u32x4*)(zrow + 1920 + col);
#pragma unroll
  for (int e = 0; e < 4; ++e) {
    o[2 * e] = w[2 * e] * bflo(zp[e]) + w[8 + 2 * e] * bflo(zc[e]) + w[16 + 2 * e] * bflo(zn[e]);
    o[2 * e + 1] = w[2 * e + 1] * bfhi(zp[e]) + w[8 + 2 * e + 1] * bfhi(zc[e]) + w[16 + 2 * e + 1] * bfhi(zn[e]);
  }
}
DI u32x4 pack8(const float (&o)[8]) { return (u32x4){pk2(o[0], o[1]), pk2(o[2], o[3]), pk2(o[4], o[5]), pk2(o[6], o[7])}; }

struct ZL3 { u32x4 c, p, n; };
DI void load_z3(ZL3& z, const bf16_t* zrow, int col, bool hp, bool hn) {
  z.c = *(const u32x4*)(zrow + col);
  z.p = (u32x4){0, 0, 0, 0}; z.n = (u32x4){0, 0, 0, 0};
  if (hp) z.p = *(const u32x4*)(zrow - 1920 + col);
  if (hn) z.n = *(const u32x4*)(zrow + 1920 + col);
}
DI void conv_z3(float (&o)[8], const ZL3& z, const float (&w)[24]) {
#pragma unroll
  for (int e = 0; e < 4; ++e) {
    o[2 * e] = w[2 * e] * bflo(z.p[e]) + w[8 + 2 * e] * bflo(z.c[e]) + w[16 + 2 * e] * bflo(z.n[e]);
    o[2 * e + 1] = w[2 * e + 1] * bfhi(z.p[e]) + w[8 + 2 * e + 1] * bfhi(z.c[e]) + w[16 + 2 * e + 1] * bfhi(z.n[e]);
  }
}
DI void phase2(const Params& p) {
  char* ws = launder(p.ws);
  const bf16_t* zrw = (const bf16_t*)(ws + OFF_ZRW);
  bf16_t *R = (bf16_t*)(ws + OFF_R), *K = (bf16_t*)(ws + OFF_K), *V = (bf16_t*)(ws + OFF_V), *TW = (bf16_t*)(ws + OFF_TW), *ZA = (bf16_t*)(ws + OFF_ZA), *SG = (bf16_t*)(ws + OFF_SG);
  float *kinv = (float*)(ws + OFF_KINV), *rkdot = (float*)(ws + OFF_RKDOT), *rsq = (float*)(ws + OFF_RSQ), *rskv = (float*)(ws + OFF_RSKV), *cs = (float*)(ws + OFF_CS);
  const bf16_t *zq = (const bf16_t*)(ws + OFF_ZQ), *zkv = (const bf16_t*)(ws + OFF_ZKV), *zkr = (const bf16_t*)(ws + OFF_ZKR);
  bf16_t* kpe = (bf16_t*)(ws + OFF_KPE);
  const int lane = tidx() & 63, wid = tidx() >> 6;
  const float invf = powf(10000.f, -(float)(lane & 15) * (1.f / 16.f));
  float cwr[24], cwk[24], cwv[24], kkw[8], rkw[8];
  load_cw(cwr, p.rw_conv, 8 * lane); load_cw(cwk, p.rw_conv, 512 + 8 * lane); load_cw(cwv, p.rw_conv, 1024 + 8 * lane);
  float cwx[24];
  load_cw(cwx, p.rw_conv, 1536 + 8 * (lane < 48 ? lane : 0));
#pragma unroll
  for (int e = 0; e < 8; ++e) { kkw[e] = p.rw_k_k[8 * lane + e]; rkw[e] = p.rw_r_k[8 * lane + e]; }
  const int l47 = lane < 48 ? lane : 47, l31 = lane & 31, l15 = lane & 15;
  for (int tok = blockIdx.x * 8 + wid; tok < NTOK; tok += gridDim.x * 8) {
    const int s = tok % SEQ; const bool hp = s > 0, hn = s < SEQ - 1;
    const bf16_t* zrow = zrw + (size_t)tok * 1920;
    ZL3 zr, zk, zv, zx;
    load_z3(zr, zrow, 8 * lane, hp, hn); load_z3(zk, zrow, 512 + 8 * lane, hp, hn); load_z3(zv, zrow, 1024 + 8 * lane, hp, hn);
    load_z3(zx, zrow, 1536 + 8 * l47, hp, hn);
    const u32x4 zqv = *(const u32x4*)(zq + (size_t)tok * 384 + 8 * l47);
    const u32x4 zkvv = *(const u32x4*)(zkv + (size_t)tok * 256 + 8 * l31);
    const unsigned short kr1 = zkr[(size_t)tok * 32 + l15], kr2 = zkr[(size_t)tok * 32 + 16 + l15];
    const int posv = p.pos[tok];
    float r8[8], k8[8], v8[8];
    conv_z3(r8, zr, cwr); conv_z3(k8, zk, cwk); conv_z3(v8, zv, cwv);
    *(u32x4*)(R + (size_t)tok * 512 + 8 * lane) = pack8(r8);
    *(u32x4*)(K + (size_t)tok * 512 + 8 * lane) = pack8(k8);
    *(u32x4*)(V + (size_t)tok * 512 + 8 * lane) = pack8(v8);
    float ss = 0.f, rk = 0.f;
#pragma unroll
    for (int e = 0; e < 8; ++e) { const float kk = k8[e] * kkw[e]; ss += kk * kk; rk += r8[e] * k8[e] * rkw[e]; }
    ss += __shfl_xor(ss, 1); ss += __shfl_xor(ss, 2); ss += __shfl_xor(ss, 4);
    rk += __shfl_xor(rk, 1); rk += __shfl_xor(rk, 2); rk += __shfl_xor(rk, 4);
    if ((lane & 7) == 0) { kinv[(size_t)tok * 8 + (lane >> 3)] = 1.f / fmaxf(sqrtf(ss), 1e-12f); rkdot[(size_t)tok * 8 + (lane >> 3)] = rk; }
    if (lane < 48) {
      float o[8];
      conv_z3(o, zx, cwx);
      if (lane < 16) {
#pragma unroll
        for (int e = 0; e < 8; ++e) o[e] = 1.f - 2.f / (1.f + __expf(2.f * o[e]));
        *(u32x4*)(TW + (size_t)tok * 128 + 8 * lane) = pack8(o);
      } else if (lane < 32) {
        *(u32x4*)(ZA + (size_t)tok * 128 + 8 * (lane - 16)) = pack8(o);
      } else {
#pragma unroll
        for (int e = 0; e < 8; ++e) o[e] = sigm(o[e]);
        *(u32x4*)(SG + (size_t)tok * 128 + 8 * (lane - 32)) = pack8(o);
      }
    }
    float sq = 0.f, skv = 0.f;
    if (lane < 48) {
#pragma unroll
      for (int e = 0; e < 4; ++e) { const float a = bflo(zqv[e]), b2 = bfhi(zqv[e]); sq += a * a + b2 * b2; } }
    if (lane < 32) {
#pragma unroll
      for (int e = 0; e < 4; ++e) { const float a = bflo(zkvv[e]), b2 = bfhi(zkvv[e]); skv += a * a + b2 * b2; } }
#pragma unroll
    for (int m = 1; m < 64; m <<= 1) { sq += __shfl_xor(sq, m); skv += __shfl_xor(skv, m); }
    if (lane == 0) { rsq[tok] = rsqrtf(sq * (1.f / 384.f) + 1e-6f); rskv[tok] = rsqrtf(skv * (1.f / 256.f) + 1e-6f); }
    if (lane < 16) {
      const float ang = (float)posv * invf;
      float si, co; sincosf(ang, &si, &co);
      cs[(size_t)tok * 32 + lane] = co; cs[(size_t)tok * 32 + 16 + lane] = si;
      const float x1 = bf2f(kr1), x2 = bf2f(kr2);
      kpe[(size_t)tok * 32 + lane] = f2bf(x1 * co - x2 * si);
      kpe[(size_t)tok * 32 + 16 + lane] = f2bf(x1 * si + x2 * co);
    }
  }
}

DI void scan_item(const Params& p, int pair, char* smem0) {
  char* ws = launder(p.ws);
  const int tid = tidx(), lane = tid & 63, w = (tid >> 6) & 3, half = __builtin_amdgcn_readfirstlane(tid >> 8);
  const int item = pair * 2 + half;
  const int dir = item & 1, h = (item >> 1) & 7, b = item >> 4;
  char* smem = smem0 + half * 53248;
  float* opbuf = (float*)smem;
  float* ybuf = (float*)(smem + 49152) + w * 256;
  const bf16_t *R = (const bf16_t*)(ws + OFF_R), *K = (const bf16_t*)(ws + OFF_K), *V = (const bf16_t*)(ws + OFF_V), *TW = (const bf16_t*)(ws + OFF_TW), *ZA = (const bf16_t*)(ws + OFF_ZA);
  const float* kinv = (const float*)(ws + OFF_KINV);
  bf16_t* Y = (bf16_t*)(ws + (dir ? OFF_YB : OFF_YF));
  const int n = w * 16 + (lane & 15), gc = h * 64 + n;
  bf16x8 bw[2], ba[2];
#pragma unroll
  for (int ks = 0; ks < 2; ++ks) {
    bw[ks] = *(const bf16x8*)((const bf16_t*)(ws + OFF_WW2) + ((size_t)(dir * 512 + gc)) * 64 + ks * 32 + (lane >> 4) * 8);
    ba[ks] = *(const bf16x8*)((const bf16_t*)(ws + OFF_WA2) + ((size_t)(dir * 512 + gc)) * 64 + ks * 32 + (lane >> 4) * 8);
  }
  const float w0v = p.rw_w0[dir * 512 + gc], a0v = p.rw_a0[dir * 512 + gc], kkv = p.rw_k_k[gc], kav = p.rw_k_a[gc];
  const int tokb = b * SEQ;
  auto tok_of = [&](int ci, int tau) -> int { const int t = ci * 16 + tau; return tokb + (dir ? (SEQ - 1 - t) : t); };
  bf16x8 ta[2], za[2]; unsigned short kr[4], rr[4], vr[4]; float kiv[4];
  auto prep_load = [&](int ci) {
    const int tk = tok_of(ci, lane & 15);
#pragma unroll
    for (int ks = 0; ks < 2; ++ks) {
      ta[ks] = *(const bf16x8*)(TW + (size_t)tk * 128 + dir * 64 + ks * 32 + (lane >> 4) * 8);
      za[ks] = *(const bf16x8*)(ZA + (size_t)tk * 128 + dir * 64 + ks * 32 + (lane >> 4) * 8);
    }
#pragma unroll
    for (int j = 0; j < 4; ++j) {
      const int t2 = tok_of(ci, (lane >> 4) * 4 + j);
      kr[j] = K[(size_t)t2 * 512 + gc]; rr[j] = R[(size_t)t2 * 512 + gc]; vr[j] = V[(size_t)t2 * 512 + gc]; kiv[j] = kinv[(size_t)t2 * 8 + h];
    }
  };
  auto prep_finish = [&](int stage) {
    f32x4 aw = (f32x4){0.f, 0.f, 0.f, 0.f}, aa = aw;
    aw = __builtin_amdgcn_mfma_f32_16x16x32_bf16(ta[0], bw[0], aw, 0, 0, 0); aw = __builtin_amdgcn_mfma_f32_16x16x32_bf16(ta[1], bw[1], aw, 0, 0, 0);
    aa = __builtin_amdgcn_mfma_f32_16x16x32_bf16(za[0], ba[0], aa, 0, 0, 0); aa = __builtin_amdgcn_mfma_f32_16x16x32_bf16(za[1], ba[1], aa, 0, 0, 0);
#pragma unroll
    for (int j = 0; j < 4; ++j) {
      const int tau = (lane >> 4) * 4 + j;
      const float kval = bf2f(kr[j]), rval = bf2f(rr[j]), vval = bf2f(vr[j]);
      const float u = w0v + aw[j];
      const float z = -u, sp = fmaxf(z, 0.f) + __logf(1.f + __expf(-fabsf(z)));
      const float dec = __expf(-__expf(-sp - 0.5f));
      const float alr = 1.f / (1.f + __expf(-(a0v + aa[j])));
      const float kkn = kval * kkv * kiv[j];
      float* ob = opbuf + stage * 6144 + tau * 384 + n;
      ob[0] = -kkn; ob[64] = dec; ob[128] = kkn * alr; ob[192] = kval * (1.f + (alr - 1.f) * kav); ob[256] = rval; ob[320] = vval;
    }
  };
  f32x4 paw = (f32x4){0.f, 0.f, 0.f, 0.f}, paa = paw;
  auto prep_mfma = [&]() {
    f32x4 z4 = (f32x4){0.f, 0.f, 0.f, 0.f};
    paw = __builtin_amdgcn_mfma_f32_16x16x32_bf16(ta[0], bw[0], z4, 0, 0, 0); paw = __builtin_amdgcn_mfma_f32_16x16x32_bf16(ta[1], bw[1], paw, 0, 0, 0);
    paa = __builtin_amdgcn_mfma_f32_16x16x32_bf16(za[0], ba[0], z4, 0, 0, 0); paa = __builtin_amdgcn_mfma_f32_16x16x32_bf16(za[1], ba[1], paa, 0, 0, 0);
  };
  auto prep_elem = [&](int j, int stage) {
    const int tau = (lane >> 4) * 4 + j;
    const float kval = bf2f(kr[j]), rval = bf2f(rr[j]), vval = bf2f(vr[j]);
    const float u = w0v + paw[j];
    const float z = -u, sp = fmaxf(z, 0.f) + __logf(1.f + __expf(-fabsf(z)));
    const float dec = __expf(-__expf(-sp - 0.5f));
    const float alr = 1.f / (1.f + __expf(-(a0v + paa[j])));
    const float kkn = kval * kkv * kiv[j];
    float* ob = opbuf + stage * 6144 + tau * 384 + n;
    ob[0] = -kkn; ob[64] = dec; ob[128] = kkn * alr; ob[192] = kval * (1.f + (alr - 1.f) * kav); ob[256] = rval; ob[320] = vval;
  };
  float S0[8], S1[8];
#pragma unroll
  for (int c = 0; c < 8; ++c) { S0[c] = 0.f; S1[c] = 0.f; }
  const int cq = lane & 7, rp = lane >> 3, irow = w * 16 + 2 * rp;
  struct Ops { f32x4 a0, a1, w0, w1, b0, b1, k0, k1, r0, r1; f32x2 v; };
  auto load_ops = [&](Ops& o, const float* obase, int tau) {
    const float* ob = obase + tau * 384 + cq * 8;
    o.a0 = *(const f32x4*)(ob); o.a1 = *(const f32x4*)(ob + 4);
    o.v = *(const f32x2*)(obase + tau * 384 + 320 + irow);
    o.w0 = *(const f32x4*)(ob + 64); o.w1 = *(const f32x4*)(ob + 68);
    o.b0 = *(const f32x4*)(ob + 128); o.b1 = *(const f32x4*)(ob + 132);
    o.k0 = *(const f32x4*)(ob + 192); o.k1 = *(const f32x4*)(ob + 196);
    o.r0 = *(const f32x4*)(ob + 256); o.r1 = *(const f32x4*)(ob + 260);
  };
  auto red8 = [&](float x) -> float { x += dppf<0xB1>(x); x += dppf<0x4E>(x); x += dppf<0x141>(x); return x; };
  auto step = [&](const Ops& o, int tau) {
    float A[8], W[8], Bv[8], Kv[8], Rv[8];
#pragma unroll
    for (int e = 0; e < 4; ++e) { A[e] = o.a0[e]; A[4 + e] = o.a1[e]; W[e] = o.w0[e]; W[4 + e] = o.w1[e]; Bv[e] = o.b0[e]; Bv[4 + e] = o.b1[e];
      Kv[e] = o.k0[e]; Kv[4 + e] = o.k1[e]; Rv[e] = o.r0[e]; Rv[4 + e] = o.r1[e]; }
    float sa0 = mul_s(S0[0], A[0]), sa1 = mul_s(S1[0], A[0]);
#pragma unroll
    for (int c = 1; c < 8; ++c) { sa0 = fma_s(S0[c], A[c], sa0); sa1 = fma_s(S1[c], A[c], sa1); }
    float t0[8], t1[8];
#pragma unroll
    for (int c = 0; c < 8; ++c) { t0[c] = mul_s(o.v[0], Kv[c]); t1[c] = mul_s(o.v[1], Kv[c]); }
    sa0 = red8(sa0); sa1 = red8(sa1);
    float y0 = 0.f, y1 = 0.f;
#pragma unroll
    for (int c = 0; c < 8; ++c) {
      S0[c] = fma_s(S0[c], W[c], fma_s(sa0, Bv[c], t0[c]));
      S1[c] = fma_s(S1[c], W[c], fma_s(sa1, Bv[c], t1[c]));
      y0 = fma_s(S0[c], Rv[c], y0); y1 = fma_s(S1[c], Rv[c], y1);
    }
    y0 = red8(y0); y1 = red8(y1);
    if (cq == 0) *(f32x2*)(ybuf + tau * 16 + 2 * rp) = (f32x2){y0, y1};
  };
  prep_load(0); prep_finish(0); prep_load(1);
  __syncthreads();
  for (int ci = 0; ci < SEQ / 16; ++ci) {
    const bool more = ci + 1 < SEQ / 16;
    const float* obase = opbuf + (ci & 1) * 6144;
    Ops oa, ob2;
    load_ops(oa, obase, 0);
#pragma unroll
    for (int tau = 0; tau < 16; tau += 2) {
      load_ops(ob2, obase, tau + 1);
      __builtin_amdgcn_sched_barrier(0);
      step(oa, tau);
      if (more) { if (tau == 0) prep_mfma(); else if ((tau & 3) == 2) prep_elem((tau - 2) >> 2, (ci + 1) & 1); }
      __builtin_amdgcn_sched_barrier(0);
      if (tau + 2 < 16) load_ops(oa, obase, tau + 2);
      __builtin_amdgcn_sched_barrier(0);
      step(ob2, tau + 1);
      __builtin_amdgcn_sched_barrier(0);
    }
    {
      const int tau = lane >> 2, r4 = (lane & 3) * 4;
      const f32x4 yv = *(const f32x4*)(ybuf + tau * 16 + r4);
      *(u32x2*)(Y + (size_t)tok_of(ci, tau) * 512 + h * 64 + w * 16 + r4) = (u32x2){pk2(yv[0], yv[1]), pk2(yv[2], yv[3])};
    }
    if (ci + 2 < SEQ / 16) prep_load(ci + 2);
    __syncthreads();
  }
}

constexpr int KROW = 208, VROW = 136, KT_BYTES = 64 * KROW, VT_BYTES = 64 * VROW, ATT_STAGE = KT_BYTES + VT_BYTES;
DI int crow16(int i, int hh) { return (i & 3) + 8 * (i >> 2) + 4 * hh; }
DI void attn_item(const Params& p, int item, char* smem) {
  char* ws = launder(p.ws);
  const int qb = item & 7, bh = item >> 3, b = bh >> 3, h = bh & 7;
  const int tid = tidx(), lane = tid & 63, w = tid >> 6, l31 = lane & 31, hh = lane >> 5;
  const bf16_t* Q = (const bf16_t*)(ws + OFF_Q) + ((size_t)bh * SEQ + qb * 256 + w * 32 + l31) * 96;
  const bf16_t* Kn = (const bf16_t*)(ws + OFF_KN) + (size_t)bh * SEQ * 64;
  const bf16_t* Kpe = (const bf16_t*)(ws + OFF_KPE) + (size_t)b * SEQ * 32;
  const bf16_t* VT = (const bf16_t*)(ws + OFF_VT) + (size_t)bh * 64 * SEQ;
  bf16x8 qf[6];
#pragma unroll
  for (int ks = 0; ks < 6; ++ks) qf[ks] = *(const bf16x8*)(Q + ks * 16 + hh * 8);
  u32x4 kreg[2], vreg[1];
  auto gload = [&](int kt) {
    const int k0 = kt * 64;
#pragma unroll
    for (int i = 0; i < 2; ++i) { const int cid = tid + 512 * i, key = cid / 12, c = cid % 12;
      if (cid < 768) kreg[i] = (c < 8) ? *(const u32x4*)(Kn + (size_t)(k0 + key) * 64 + c * 8) : *(const u32x4*)(Kpe + (size_t)(k0 + key) * 32 + (c - 8) * 8); }
#pragma unroll
    for (int i = 0; i < 1; ++i) { const int cid = tid, dv = cid >> 3, c = cid & 7; vreg[i] = *(const u32x4*)(VT + (size_t)dv * SEQ + k0 + c * 8); }
  };
  auto lstore = [&](int stage) {
    char* st = smem + stage * ATT_STAGE;
#pragma unroll
    for (int i = 0; i < 2; ++i) { const int cid = tid + 512 * i, key = cid / 12, c = cid % 12; if (cid < 768) *(u32x4*)(st + key * KROW + c * 16) = kreg[i]; }
#pragma unroll
    for (int i = 0; i < 1; ++i) { const int cid = tid, dv = cid >> 3, c = cid & 7; char* d = st + KT_BYTES + dv * VROW + c * 16;
      *(u32x2*)d = (u32x2){vreg[i][0], vreg[i][1]}; *(u32x2*)(d + 8) = (u32x2){vreg[i][2], vreg[i][3]}; }
  };
  f32x16 o0, o1;
#pragma unroll
  for (int i = 0; i < 16; ++i) { o0[i] = 0.f; o1[i] = 0.f; }
  float mrun = 0.f, lsum = 0.f;
  f32x16 negm;
#pragma unroll
  for (int i = 0; i < 16; ++i) negm[i] = 0.f;
  gload(0); lstore(0);
  __syncthreads();
  for (int kt = 0; kt < SEQ / 64; ++kt) {
    const bool more = kt + 1 < SEQ / 64;
    if (more) gload(kt + 1);
    __builtin_amdgcn_sched_barrier(0);
    const char* st = smem + (kt & 1) * ATT_STAGE;
    f32x16 s0 = negm, s1 = negm;
#pragma unroll
    for (int ks = 0; ks < 6; ++ks) {
      const bf16x8 k0f = *(const bf16x8*)(st + l31 * KROW + ks * 32 + hh * 16);
      const bf16x8 k1f = *(const bf16x8*)(st + (32 + l31) * KROW + ks * 32 + hh * 16);
      s0 = __builtin_amdgcn_mfma_f32_32x32x16_bf16(k0f, qf[ks], s0, 0, 0, 0);
      s1 = __builtin_amdgcn_mfma_f32_32x32x16_bf16(k1f, qf[ks], s1, 0, 0, 0);
    }
    float mx = fmaxf(s0[0], s1[0]);
#pragma unroll
    for (int i = 1; i < 16; ++i) mx = fmaxf(mx, fmaxf(s0[i], s1[i]));
    mx = fmaxf(mx, __shfl_xor(mx, 32));
    if (kt == 0 || __any(mx > 8.f)) {
      const float alpha = __builtin_amdgcn_exp2f(-mx);
      mrun += mx; lsum *= alpha;
#pragma unroll
      for (int i = 0; i < 16; ++i) { s0[i] -= mx; s1[i] -= mx; o0[i] *= alpha; o1[i] *= alpha; negm[i] = -mrun; }
    }
    float ps = 0.f;
#pragma unroll
    for (int i = 0; i < 16; ++i) { s0[i] = __builtin_amdgcn_exp2f(s0[i]); s1[i] = __builtin_amdgcn_exp2f(s1[i]); ps += s0[i] + s1[i]; }
    lsum += ps;
    const char* vt = st + KT_BYTES;
#pragma unroll
    for (int s4 = 0; s4 < 4; ++s4) {
      const int ss = s4 & 1;
      u32x4 pw;
      if (s4 < 2) pw = (u32x4){pk2(s0[8 * ss], s0[8 * ss + 1]), pk2(s0[8 * ss + 2], s0[8 * ss + 3]), pk2(s0[8 * ss + 4], s0[8 * ss + 5]), pk2(s0[8 * ss + 6], s0[8 * ss + 7])};
      else pw = (u32x4){pk2(s1[8 * ss], s1[8 * ss + 1]), pk2(s1[8 * ss + 2], s1[8 * ss + 3]), pk2(s1[8 * ss + 4], s1[8 * ss + 5]), pk2(s1[8 * ss + 6], s1[8 * ss + 7])};
      const bf16x8 pf = __builtin_bit_cast(bf16x8, pw);
      const int koff = (s4 * 16 + 4 * hh) * 2;
      const u32x2 a0 = *(const u32x2*)(vt + l31 * VROW + koff), a1 = *(const u32x2*)(vt + l31 * VROW + koff + 16);
      const u32x2 b0 = *(const u32x2*)(vt + (32 + l31) * VROW + koff), b1 = *(const u32x2*)(vt + (32 + l31) * VROW + koff + 16);
      const bf16x8 v0f = __builtin_bit_cast(bf16x8, ((u32x4){a0[0], a0[1], a1[0], a1[1]}));
      const bf16x8 v1f = __builtin_bit_cast(bf16x8, ((u32x4){b0[0], b0[1], b1[0], b1[1]}));
      o0 = __builtin_amdgcn_mfma_f32_32x32x16_bf16(v0f, pf, o0, 0, 0, 0);
      o1 = __builtin_amdgcn_mfma_f32_32x32x16_bf16(v1f, pf, o1, 0, 0, 0);
    }
    __builtin_amdgcn_sched_barrier(0);
    if (more) lstore((kt + 1) & 1);
    __syncthreads();
  }
  lsum += __shfl_xor(lsum, 32);
  const float inv = 1.f / lsum;
  bf16_t* O = (bf16_t*)(ws + OFF_YMLA) + ((size_t)b * SEQ + qb * 256 + w * 32 + l31) * 512 + h * 64;
#pragma unroll
  for (int g = 0; g < 4; ++g) {
    const int dv = 8 * g + 4 * hh;
    *(u32x2*)(O + dv) = (u32x2){pk2(o0[4 * g] * inv, o0[4 * g + 1] * inv), pk2(o0[4 * g + 2] * inv, o0[4 * g + 3] * inv)};
    *(u32x2*)(O + 32 + dv) = (u32x2){pk2(o1[4 * g] * inv, o1[4 * g + 1] * inv), pk2(o1[4 * g + 2] * inv, o1[4 * g + 3] * inv)};
  }
}

DI void phase5(const Params& p, char* smem) {
  char* ws = launder(p.ws);
  bf16_t* mixed = (bf16_t*)(ws + OFF_MIXED);
  const int lane = tidx() & 63, wid = tidx() >> 6;
  const int nT = (NTOK / 256) * 4;
  for (int t2 = 2 * blockIdx.x; t2 < 2 * nT; t2 += 2 * gridDim.x) {
    for (int pass = 0; pass < 2; ++pass) {
      const int t = t2 >> 1;
      const int m0 = (t >> 2) * 256, n0 = (t & 3) * 256;
      const int rb = m0 + (wid >> 2) * 128, cb = n0 + (wid & 3) * 64;
      const bf16_t* Aop = (const bf16_t*)(ws + (pass ? OFF_YMLA : OFF_YRW));
      const bf16_t* Wop = (const bf16_t*)(ws + (pass ? OFF_WBR2 : OFF_WBR1));
      const bf16_t* gate = (const bf16_t*)(ws + (pass ? OFF_GB : OFF_GA));
      f32x4 acc[MI][4];
      zero_acc(acc);
      gemm_tile_acc(acc, Aop, 512, Wop, 512, m0, n0, 512, smem);
#pragma unroll
      for (int mi = 0; mi < MI; ++mi) {
        int row_ = rb + mi * 16 + (lane & 15); asm volatile("" : "+v"(row_) :: "memory");
#pragma unroll
        for (int ni = 0; ni < 4; ++ni) {
          const size_t o = (size_t)row_ * DM + cb + ni * 16 + (lane >> 4) * 4;
          const u32x2 g = *(const u32x2*)(gate + o);
          f32x4 v = acc[mi][ni] * (f32x4){bflo(g[0]), bfhi(g[0]), bflo(g[1]), bfhi(g[1])};
          if (pass) { const u32x2 mm = *(const u32x2*)(mixed + o); v += (f32x4){bflo(mm[0]), bfhi(mm[0]), bflo(mm[1]), bfhi(mm[1])}; }
          *(u32x2*)(mixed + o) = (u32x2){pk2(v[0], v[1]), pk2(v[2], v[3])};
        }
      }
    }
  }
}

template <bool WITH_H>
DI void ln_phase(const float* in, float* outp, const float* __restrict__ g, const float* __restrict__ be, const float* mod, bf16_t* hout) {
  const int lane = tidx() & 63, wid = tidx() >> 6;
  constexpr int R = 4;
  for (int rb = (blockIdx.x * 8 + wid) * R; rb < NTOK; rb += gridDim.x * 8 * R) {
    f32x4 v[R][4]; float s[R], q[R];
#pragma unroll
    for (int r = 0; r < R; ++r)
#pragma unroll
      for (int i = 0; i < 4; ++i) v[r][i] = *(const f32x4*)(in + (size_t)(rb + r) * DM + i * 256 + lane * 4);
#pragma unroll
    for (int r = 0; r < R; ++r) { s[r] = 0.f;
#pragma unroll
      for (int i = 0; i < 4; ++i) s[r] += (v[r][i][0] + v[r][i][1]) + (v[r][i][2] + v[r][i][3]); }
#pragma unroll
    for (int m = 1; m < 64; m <<= 1)
#pragma unroll
      for (int r = 0; r < R; ++r) s[r] += __shfl_xor(s[r], m);
#pragma unroll
    for (int r = 0; r < R; ++r) { const float mean = s[r] * (1.f / 1024.f); s[r] = mean; q[r] = 0.f;
#pragma unroll
      for (int i = 0; i < 4; ++i) { const f32x4 d = v[r][i] - mean; q[r] += (d[0] * d[0] + d[1] * d[1]) + (d[2] * d[2] + d[3] * d[3]); } }
#pragma unroll
    for (int m = 1; m < 64; m <<= 1)
#pragma unroll
      for (int r = 0; r < R; ++r) q[r] += __shfl_xor(q[r], m);
    const int b = rb / SEQ;
#pragma unroll
    for (int r = 0; r < R; ++r) {
      const int row = rb + r;
      const float mean = s[r], rstd = rsqrtf(q[r] * (1.f / 1024.f) + 1e-5f);
      if (WITH_H && lane == 0) *(f32x2*)(outp + (size_t)row * 2) = (f32x2){mean, rstd};
#pragma unroll
      for (int i = 0; i < 4; ++i) {
        const int col = i * 256 + lane * 4;
        const f32x4 o = (v[r][i] - mean) * rstd * *(const f32x4*)(g + col) + *(const f32x4*)(be + col);
        if (!WITH_H) *(f32x4*)(outp + (size_t)row * DM + col) = o;
        if (WITH_H) {
          const f32x4 sh = *(const f32x4*)(mod + b * 6144 + 3072 + col), sc = *(const f32x4*)(mod + b * 6144 + 4096 + col) + 1.f;
          const f32x4 hv = o * sc + sh;
          *(u32x2*)(hout + (size_t)row * DM + col) = (u32x2){pk2(hv[0], hv[1]), pk2(hv[2], hv[3])};
        }
      }
    }
  }
}

template <bool FINAL>
DI void ln1_phase(const bf16_t* in, float* stats, const float* __restrict__ g, const float* __restrict__ be, const float* mod, bf16_t* hout) {
  const int lane = tidx() & 63, wid = tidx() >> 6;
  constexpr int R = 4;
  for (int rb = (blockIdx.x * 8 + wid) * R; rb < NTOK; rb += gridDim.x * 8 * R) {
    u32x4 raw[R][2]; f32x4 v[R][4]; float s[R], q[R];
#pragma unroll
    for (int r = 0; r < R; ++r)
#pragma unroll
      for (int i = 0; i < 2; ++i) raw[r][i] = *(const u32x4*)(in + (size_t)(rb + r) * DM + i * 512 + lane * 8);
#pragma unroll
    for (int r = 0; r < R; ++r) { s[r] = 0.f;
#pragma unroll
      for (int i = 0; i < 2; ++i) {
        v[r][2 * i] = (f32x4){bflo(raw[r][i][0]), bfhi(raw[r][i][0]), bflo(raw[r][i][1]), bfhi(raw[r][i][1])};
        v[r][2 * i + 1] = (f32x4){bflo(raw[r][i][2]), bfhi(raw[r][i][2]), bflo(raw[r][i][3]), bfhi(raw[r][i][3])};
        s[r] += ((v[r][2 * i][0] + v[r][2 * i][1]) + (v[r][2 * i][2] + v[r][2 * i][3])) + ((v[r][2 * i + 1][0] + v[r][2 * i + 1][1]) + (v[r][2 * i + 1][2] + v[r][2 * i + 1][3]));
      } }
#pragma unroll
    for (int m = 1; m < 64; m <<= 1)
#pragma unroll
      for (int r = 0; r < R; ++r) s[r] += __shfl_xor(s[r], m);
#pragma unroll
    for (int r = 0; r < R; ++r) { const float mean = s[r] * (1.f / 1024.f); s[r] = mean; q[r] = 0.f;
#pragma unroll
      for (int i = 0; i < 4; ++i) { const f32x4 d = v[r][i] - mean; q[r] += (d[0] * d[0] + d[1] * d[1]) + (d[2] * d[2] + d[3] * d[3]); } }
#pragma unroll
    for (int m = 1; m < 64; m <<= 1)
#pragma unroll
      for (int r = 0; r < R; ++r) q[r] += __shfl_xor(q[r], m);
    const int b = rb / SEQ;
#pragma unroll
    for (int r = 0; r < R; ++r) {
      const int row = rb + r;
      const float mean = s[r], rstd = rsqrtf(q[r] * (1.f / 1024.f) + 1e-5f);
      if (!FINAL && lane == 0) *(f32x2*)(stats + (size_t)row * 2) = (f32x2){mean, rstd};
#pragma unroll
      for (int i = 0; i < 2; ++i) {
        const int col = i * 512 + lane * 8;
        f32x4 hv[2];
#pragma unroll
        for (int hh = 0; hh < 2; ++hh) {
          const int c = col + 4 * hh;
          const f32x4 o = (v[r][2 * i + hh] - mean) * rstd * *(const f32x4*)(g + c) + *(const f32x4*)(be + c);
          if (FINAL) { *(f32x4*)(stats + (size_t)row * DM + c) = o; hv[hh] = o; }
          else { const f32x4 sh = *(const f32x4*)(mod + b * 6144 + 3072 + c), sc = *(const f32x4*)(mod + b * 6144 + 4096 + c) + 1.f; hv[hh] = o * sc + sh; }
        }
        if (!FINAL) *(u32x4*)(hout + (size_t)row * DM + col) = (u32x4){pk2(hv[0][0], hv[0][1]), pk2(hv[0][2], hv[0][3]), pk2(hv[1][0], hv[1][1]), pk2(hv[1][2], hv[1][3])};
      }
    }
  }
}

DI void gsync(unsigned* bar, unsigned& target) {
  asm volatile("s_waitcnt vmcnt(0) lgkmcnt(0)" ::: "memory");
  __syncthreads();
  target += gridDim.x;
  if (tidx() == 0) {
    __builtin_amdgcn_fence(__ATOMIC_RELEASE, "agent");
    asm volatile("s_waitcnt vmcnt(0)" ::: "memory");
    __hip_atomic_fetch_add(bar, 1u, __ATOMIC_RELAXED, __HIP_MEMORY_SCOPE_AGENT);
    while (__hip_atomic_load(bar, __ATOMIC_RELAXED, __HIP_MEMORY_SCOPE_AGENT) < target) __builtin_amdgcn_s_sleep(4);
    __builtin_amdgcn_fence(__ATOMIC_ACQUIRE, "agent");
    asm volatile("s_waitcnt vmcnt(0)" ::: "memory");
  }
  __syncthreads();
}

__global__ void __launch_bounds__(512, 2) fwd_mega(Params p) {
  __shared__ __attribute__((aligned(16))) char smem[131072];
  cg::grid_group grid = cg::this_grid();
  char* ws = launder(p.ws);
  unsigned* bar = (unsigned*)p.ws; unsigned target = 0;
  phase0a(p, smem);
  grid.sync();
  phase0b(p, smem);
  gsync(bar, target);
  ws = launder(ws);
  { InElem e{ws}; pg8_gemm8(smem, (const bf16_t*)(ws + OFF_HBF), (const bf16_t*)(ws + OFF_WIN), NTOK, DIN_PAD, DM, e); }
  gsync(bar, target);
  phase2(p);
  gsync(bar, target);
  ws = launder(ws);
  { EpiQ e{ws}; gemm_phase((const bf16_t*)(ws + OFF_ZQ), 384, (const bf16_t*)(ws + OFF_WUQ), 384, NTOK, 768, 384, smem, e); }
  ws = launder(ws);
  { EpiKV e{ws}; gemm_phase((const bf16_t*)(ws + OFF_ZKV), 256, (const bf16_t*)(ws + OFF_WUKV), 256, NTOK, 1024, 256, smem, e); }
  gsync(bar, target);
  for (int it = blockIdx.x; it < 256; it += gridDim.x) scan_item(p, it, smem);
  for (int it = blockIdx.x; it < 2048; it += gridDim.x) attn_item(p, it, smem);
  gsync(bar, target);
  ws = launder(ws);
  { EpiG8 e{ws, p.rw_lnx_g, p.rw_lnx_b}; gemm_phase<EpiG8, true>((const bf16_t*)(ws + OFF_SG), 128, (const bf16_t*)(ws + OFF_WG2), 128, NTOK, 512, 128, smem, e); }
  gsync(bar, target);
  ws = launder(ws);
  { MixElem e{(const bf16_t*)(ws + OFF_GA), (bf16_t*)(ws + OFF_MIXED), 0}; pg8_gemm8(smem, (const bf16_t*)(ws + OFF_YRW), (const bf16_t*)(ws + OFF_WBR1), NTOK, DM, 512, e); }
  ws = launder(ws);
  { MixElem e{(const bf16_t*)(ws + OFF_GB), (bf16_t*)(ws + OFF_MIXED), 1}; pg8_gemm8(smem, (const bf16_t*)(ws + OFF_YMLA), (const bf16_t*)(ws + OFF_WBR2), NTOK, DM, 512, e); }
  gsync(bar, target);
  ws = launder(ws);
  { T1bElem e{p.x, (const float*)(ws + OFF_MOD) + 2048, (bf16_t*)(ws + OFF_T1)}; pg8_gemm8(smem, (const bf16_t*)(ws + OFF_MIXED), (const bf16_t*)(ws + OFF_WOUT), NTOK, DM, DM, e); }
  gsync(bar, target);
  ws = launder(ws);
  ln1_phase<false>((const bf16_t*)(ws + OFF_T1), (float*)(ws + OFF_RSQ), p.ln1_g, p.ln1_b, (const float*)(ws + OFF_MOD), (bf16_t*)(ws + OFF_HBF));
  gsync(bar, target);
  ws = launder(ws);
  { Relu2Elem e{(bf16_t*)(ws + OFF_HID)}; pg8_gemm8(smem, (const bf16_t*)(ws + OFF_HBF), (const bf16_t*)(ws + OFF_WFF1), NTOK, DFF, DM, e); }
  gsync(bar, target);
  ws = launder(ws);
  { Res2bElem e{(const bf16_t*)(ws + OFF_T1), (const float*)(ws + OFF_RSQ), p.ln1_g, p.ln1_b, (const float*)(ws + OFF_MOD) + 5120, (bf16_t*)(ws + OFF_HBF)}; pg8_gemm8(smem, (const bf16_t*)(ws + OFF_HID), (const bf16_t*)(ws + OFF_WFF2), NTOK, DM, DFF, e); }
  gsync(bar, target);
  ws = launder(ws);
  ln1_phase<true>((const bf16_t*)(ws + OFF_HBF), p.out, p.ln2_g, p.ln2_b, nullptr, nullptr);
}

extern "C" void kernel_launch(void* const* d_in, const int* in_sizes, int n_in, void* d_out, int out_size, void* d_ws, size_t ws_size, hipStream_t stream) {
  static int grid_blocks = 0;
  if (!grid_blocks) {
    int dev = 0, cus = 0, per_cu = 0;
    hipGetDevice(&dev);
    hipDeviceGetAttribute(&cus, hipDeviceAttributeMultiprocessorCount, dev);
    hipOccupancyMaxActiveBlocksPerMultiprocessor(&per_cu, fwd_mega, 512, 0);
    if (per_cu > 1) per_cu = 1;
    if (per_cu < 1) per_cu = 1;
    grid_blocks = cus * per_cu;
  }
  Params p{};
  p.x = (const float*)d_in[0]; p.c = (const float*)d_in[1]; p.pos = (const int*)d_in[2];
  p.w_ada = (const float*)d_in[3]; p.b_ada = (const float*)d_in[4]; p.w_in = (const float*)d_in[5]; p.rw_conv = (const float*)d_in[6];
  p.rw_w0 = (const float*)d_in[7]; p.rw_w2 = (const float*)d_in[8]; p.rw_a0 = (const float*)d_in[9]; p.rw_a2 = (const float*)d_in[10];
  p.rw_k_k = (const float*)d_in[11]; p.rw_k_a = (const float*)d_in[12]; p.rw_r_k = (const float*)d_in[13]; p.rw_g2 = (const float*)d_in[14];
  p.rw_lnx_g = (const float*)d_in[15]; p.rw_lnx_b = (const float*)d_in[16]; p.q_norm_g = (const float*)d_in[17]; p.kv_norm_g = (const float*)d_in[18];
  p.w_uq = (const float*)d_in[19]; p.w_ukv = (const float*)d_in[20]; p.w_br_rwkv = (const float*)d_in[21]; p.w_br_mla = (const float*)d_in[22];
  p.w_out = (const float*)d_in[23]; p.ln1_g = (const float*)d_in[24]; p.ln1_b = (const float*)d_in[25]; p.w_ff1 = (const float*)d_in[26];
  p.w_ff2 = (const float*)d_in[27]; p.ln2_g = (const float*)d_in[28]; p.ln2_b = (const float*)d_in[29];
  p.out = (float*)d_out; p.ws = (char*)d_ws;
  hipMemsetAsync(d_ws, 0, 256, stream);
  void* args[] = {&p};
  hipError_t e = hipLaunchCooperativeKernel((void*)fwd_mega, dim3(grid_blocks), dim3(512), args, 0, stream);
  if (e != hipSuccess) fprintf(stderr, "cooperative launch failed: %s (grid %d)\n", hipGetErrorString(e), grid_blocks);
}
```
